# Optimizing an MI355X kernel written in HIP

```python
import jax
import jax.numpy as jnp
from jax import lax
import numpy as np


D_MODEL = 4096
BATCH = 2
SEQ = 8192
DEPTH = 2

CTX_LEN = 256
GRID_W = 64

A_HEAD_DIM = 128
A_HEADS = (D_MODEL // 2) // A_HEAD_DIM
A_KV_HEADS = 4
A_WINDOW = 128
A_BLOCK = 128
ROPE_THETA = 10000.0
B_WIDTH = D_MODEL // 2
B_HEAD_DIM = 64
B_HEADS = B_WIDTH // B_HEAD_DIM
DECAY_LORA = 96
AAA_LORA = 96
GN_EPS = 64e-5
C_WIDTH = 3 * D_MODEL
C_CHUNK = 128
C_GROUPS = 16
LN_EPS = 1e-5
NORM_EPS = 1e-6

A_Q = A_HEADS * A_HEAD_DIM
A_KV = A_KV_HEADS * A_HEAD_DIM
AB_WIDTHS = (A_Q, A_KV, A_KV, A_Q, B_WIDTH, B_WIDTH, B_WIDTH, B_WIDTH, 2 * DECAY_LORA, 2 * AAA_LORA)
AB_IN = sum(AB_WIDTHS)
AB_SPLITS = tuple(int(s) for s in np.cumsum(AB_WIDTHS)[:-1])
AB_MIX = A_Q + B_WIDTH
N_EVEN = (DEPTH + 1) // 2
N_ODD = DEPTH // 2

kernel_name = 'hybrid_swa_rwkv7_gmlp_dit_block'


def rms_norm(x, g):
    xf = x.astype(jnp.float32)
    y = xf * lax.rsqrt(jnp.mean(xf * xf, axis=-1, keepdims=True) + NORM_EPS)
    return (y * g.astype(jnp.float32)).astype(x.dtype)


def layer_norm(x, g, b, eps):
    xf = x.astype(jnp.float32)
    xc = xf - jnp.mean(xf, axis=-1, keepdims=True)
    var = jnp.mean(xc * xc, axis=-1, keepdims=True)
    return xc * lax.rsqrt(var + eps) * g.astype(jnp.float32) + b.astype(jnp.float32)


def centred_conv3(x, w):
    xp = jnp.pad(x, ((0, 0), (1, 1), (0, 0)))
    return xp[:, :-2] * w[0] + xp[:, 1:-1] * w[1] + xp[:, 2:] * w[2]


def axial_rope_angles(n_tok):
    rows = n_tok // GRID_W
    row = jnp.repeat(jnp.arange(rows, dtype=jnp.float32), GRID_W)
    col = jnp.tile(jnp.arange(GRID_W, dtype=jnp.float32), rows)
    n_freq = A_HEAD_DIM // 4
    inv_freq = ROPE_THETA ** (-jnp.arange(n_freq, dtype=jnp.float32) / n_freq)
    return row[:, None] * inv_freq, col[:, None] * inv_freq


def rotate_half_pairs(x, ang):
    cos = jnp.cos(ang)[None, :, None, :].astype(x.dtype)
    sin = jnp.sin(ang)[None, :, None, :].astype(x.dtype)
    x1, x2 = jnp.split(x, 2, axis=-1)
    return jnp.concatenate([x1 * cos - x2 * sin, x2 * cos + x1 * sin], axis=-1)


def axial_rope(x, ang_row, ang_col):
    x_row, x_col = jnp.split(x, 2, axis=-1)
    return jnp.concatenate([rotate_half_pairs(x_row, ang_row), rotate_half_pairs(x_col, ang_col)], axis=-1)


def band_context_attention(q, k, v, kc, vc, sink):
    B, T, HQ, Dh = q.shape
    HK = k.shape[2]
    G = HQ // HK
    nb = T // A_BLOCK
    f32 = jnp.float32
    qb = q.reshape(B, nb, A_BLOCK, HK, G, Dh).astype(f32) * (Dh ** -0.5)

    def windows(t):
        tp = jnp.pad(t, ((0, 0), (A_BLOCK, A_BLOCK), (0, 0), (0, 0))).reshape(B, nb + 2, A_BLOCK, HK, Dh)
        return jnp.concatenate([tp[:, i:i + nb] for i in range(3)], axis=2).astype(f32)

    kw, vw = windows(k), windows(v)
    qpos = jnp.arange(nb)[:, None, None] * A_BLOCK + jnp.arange(A_BLOCK)[None, :, None]
    kpos = (jnp.arange(nb)[:, None, None] - 1) * A_BLOCK + jnp.arange(3 * A_BLOCK)[None, None, :]
    valid = (jnp.abs(qpos - kpos) <= A_WINDOW) & (kpos >= 0) & (kpos < T)
    s_band = jnp.einsum('bnqhgd,bnkhd->bhgnqk', qb, kw)
    s_band = jnp.where(valid, s_band, -jnp.inf)
    s_ctx = jnp.einsum('bnqhgd,blhd->bhgnql', qb, kc.astype(f32))
    s_sink = sink.astype(f32).reshape(1, HK, G, 1, 1, 1)
    m = jnp.maximum(jnp.maximum(s_band.max(-1, keepdims=True), s_ctx.max(-1, keepdims=True)), s_sink)
    p_band = jnp.exp(s_band - m)
    p_ctx = jnp.exp(s_ctx - m)
    den = jnp.exp(s_sink - m) + p_band.sum(-1, keepdims=True) + p_ctx.sum(-1, keepdims=True)
    o = (jnp.einsum('bhgnqk,bnkhd->bnqhgd', p_band / den, vw)
         + jnp.einsum('bhgnql,blhd->bnqhgd', p_ctx / den, vc.astype(f32)))
    return o.reshape(B, T, HQ * Dh).astype(q.dtype)


def context_attention(q, k, v, sink):
    B, L, HQ, Dh = q.shape
    HK = k.shape[2]
    G = HQ // HK
    f32 = jnp.float32
    qf = q.reshape(B, L, HK, G, Dh).astype(f32) * (Dh ** -0.5)
    s = jnp.einsum('blhgd,bmhd->bhglm', qf, k.astype(f32))
    s_sink = jnp.broadcast_to(sink.astype(f32).reshape(1, HK, G, 1, 1), s.shape[:-1] + (1,))
    p = jax.nn.softmax(jnp.concatenate([s_sink, s], axis=-1), axis=-1)[..., 1:]
    o = jnp.einsum('bhglm,bmhd->blhgd', p, v.astype(f32))
    return o.reshape(B, L, HQ * Dh).astype(q.dtype)


def rwkv_prep(z_r, z_k, z_v, z_w, z_a, conv_w, w0, w2, a0, a2, k_k, k_a):
    f32 = jnp.float32
    B, T, C = z_r.shape
    rkv = centred_conv3(jnp.concatenate([z_r, z_k, z_v], axis=-1), conv_w).astype(f32)
    r, k, v = jnp.split(rkv, 3, axis=-1)

    def heads(t):
        return t.reshape(t.shape[:-1] + (B_HEADS, B_HEAD_DIM))

    kk = heads(k * k_k)
    kk = kk / jnp.maximum(jnp.sqrt(jnp.sum(kk * kk, axis=-1, keepdims=True)), 1e-12)
    lw = jnp.tanh(z_w.astype(f32).reshape(B, T, 2, DECAY_LORA))
    la = z_a.astype(f32).reshape(B, T, 2, AAA_LORA)
    w_log = -jax.nn.softplus(-(w0 + jnp.einsum('btdr,drc->btdc', lw, w2))) - 0.5
    decay = jnp.exp(-jnp.exp(w_log))
    a = jax.nn.sigmoid(a0 + jnp.einsum('btdr,drc->btdc', la, a2))
    k_dir = k[:, :, None] * (1.0 + (a - 1.0) * k_a)
    return heads(r), heads(k), heads(v), kk, heads(decay), heads(k_dir), heads(a)


def wkv_scan(state, w, k, v, kk, a, r=None, reverse=False):
    def tm(t):
        return jnp.swapaxes(t, 0, 1)

    def update(S, w_t, k_t, v_t, kk_t, a_t):
        sk = jnp.einsum('bhvk,bhk->bhv', S, kk_t)
        return (S * w_t[:, :, None, :] - sk[..., None] * (kk_t * a_t)[:, :, None, :]
                + v_t[..., None] * k_t[:, :, None, :])

    xs = tuple(tm(t) for t in (w, k, v, kk, a))
    if r is None:
        S, _ = lax.scan(lambda S, inp: (update(S, *inp), None), state, xs, reverse=reverse)
        return S, None

    def step(S, inp):
        S = update(S, *inp[:5])
        return S, jnp.einsum('bhvk,bhk->bhv', S, inp[5])

    S, ys = lax.scan(step, state, xs + (tm(r),), reverse=reverse)
    return S, tm(ys)


def rwkv_readout(y, r, k, v, r_k, gn_w, gn_b):
    y = layer_norm(y, gn_w.reshape(B_HEADS, B_HEAD_DIM), gn_b.reshape(B_HEADS, B_HEAD_DIM), GN_EPS)
    y = y + jnp.sum(r * k * r_k.reshape(B_HEADS, B_HEAD_DIM).astype(jnp.float32), axis=-1, keepdims=True) * v
    return y.reshape(y.shape[:2] + (B_WIDTH,))


def ab_mixer(h_lat, h_ctx, ang_row, ang_col, w_in, w_out, sink, conv_w, w0, w2, a0, a2,
             k_k, k_a, r_k, gn_w, gn_b, ctx_out):
    zl = jnp.split(h_lat @ w_in, AB_SPLITS, axis=-1)
    zc = jnp.split(h_ctx @ w_in, AB_SPLITS, axis=-1)

    def ah(t):
        return t.reshape(t.shape[:2] + (-1, A_HEAD_DIM))

    q_l = axial_rope(ah(zl[0]), ang_row, ang_col)
    k_l = axial_rope(ah(zl[1]), ang_row, ang_col)
    v_l = ah(zl[2])
    k_c, v_c = ah(zc[1]), ah(zc[2])
    o_a = band_context_attention(q_l, k_l, v_l, k_c, v_c, sink) * jax.nn.silu(zl[3])

    r_l, kb_l, vb_l, kk_l, dec_l, kd_l, a_l = rwkv_prep(zl[4], zl[5], zl[6], zl[8], zl[9],
                                                        conv_w, w0, w2, a0, a2, k_k, k_a)
    r_c, kb_c, vb_c, kk_c, dec_c, kd_c, a_c = rwkv_prep(zc[4], zc[5], zc[6], zc[8], zc[9],
                                                        conv_w, w0, w2, a0, a2, k_k, k_a)
    B = h_lat.shape[0]
    S0 = jnp.zeros((B, B_HEADS, B_HEAD_DIM, B_HEAD_DIM), jnp.float32)
    ys_l, ys_c = [], []
    for d, rev in enumerate((False, True)):
        S_c, y_c = wkv_scan(S0, dec_c[:, :, d], kd_c[:, :, d], vb_c, kk_c, a_c[:, :, d],
                            r_c if ctx_out else None, reverse=rev)
        _, y_l = wkv_scan(S_c, dec_l[:, :, d], kd_l[:, :, d], vb_l, kk_l, a_l[:, :, d], r_l, reverse=rev)
        ys_l.append(y_l)
        ys_c.append(y_c)
    o_b = rwkv_readout(ys_l[0] + ys_l[1], r_l, kb_l, vb_l, r_k, gn_w, gn_b).astype(h_lat.dtype)
    o_b = o_b * jax.nn.silu(zl[7])
    out_l = jnp.concatenate([o_a, o_b], axis=-1) @ w_out
    if not ctx_out:
        return out_l, None
    o_ac = context_attention(ah(zc[0]), k_c, v_c, sink) * jax.nn.silu(zc[3])
    o_bc = rwkv_readout(ys_c[0] + ys_c[1], r_c, kb_c, vb_c, r_k, gn_w, gn_b).astype(h_ctx.dtype)
    o_bc = o_bc * jax.nn.silu(zc[7])
    out_c = jnp.concatenate([o_ac, o_bc], axis=-1) @ w_out
    return out_l, out_c


def gmlp_branch(h, w_in, ln_g, ln_b, w_s, b_s, w_out):
    B, T, _ = h.shape
    nc = T // C_CHUNK
    u, v, g = jnp.split(h @ w_in, 3, axis=-1)
    u = jax.nn.gelu(u)
    v = layer_norm(jax.nn.gelu(v), ln_g, ln_b, LN_EPS).astype(h.dtype)
    vb = v.reshape(B, nc, C_CHUNK, C_GROUPS, C_WIDTH // C_GROUPS)
    vm = jnp.einsum('gij,bnjgc->bnigc', w_s, vb) + b_s.T[:, :, None]
    y = u * vm.reshape(B, T, C_WIDTH) * jax.nn.silu(g)
    return y @ w_out


def setup_inputs(seed: int = 0) -> dict:
    key = jax.random.key(seed)
    keys = iter(jax.random.split(key, 40))

    def nrm(shape, std):
        return jax.random.normal(next(keys), shape, jnp.float32) * std

    D = D_MODEL
    conv_base = jnp.array([0.25, 0.5, 0.25], jnp.float32)[None, :, None]
    return {
        'x': nrm((BATCH, SEQ, D), 1.0),
        'c': nrm((BATCH, D), 1.0),
        'ctx': nrm((BATCH, CTX_LEN, D), 1.0),
        'c_ctx': nrm((D,), 1.0),
        'mod_w': nrm((DEPTH, D, 3 * D), 0.5 * D ** -0.5),
        'mod_b': nrm((DEPTH, 3 * D), 0.02),
        'norm_g': 1.0 + nrm((DEPTH, D), 0.02),
        'ab_w_in': nrm((N_EVEN, D, AB_IN), D ** -0.5),
        'ab_w_out': nrm((N_EVEN, AB_MIX, D), AB_MIX ** -0.5),
        'attn_sink': nrm((N_EVEN, A_HEADS), 1.0),
        'rwkv_conv': conv_base + nrm((N_EVEN, 3, 3 * B_WIDTH), 0.1),
        'rwkv_w0': -1.0 + nrm((N_EVEN, 2, B_WIDTH), 1.0),
        'rwkv_w2': nrm((N_EVEN, 2, DECAY_LORA, B_WIDTH), 0.5 * DECAY_LORA ** -0.5),
        'rwkv_a0': nrm((N_EVEN, 2, B_WIDTH), 0.5),
        'rwkv_a2': nrm((N_EVEN, 2, AAA_LORA, B_WIDTH), 0.5 * AAA_LORA ** -0.5),
        'rwkv_k_k': 0.85 + nrm((N_EVEN, B_WIDTH), 0.05),
        'rwkv_k_a': 1.0 + nrm((N_EVEN, B_WIDTH), 0.05),
        'rwkv_r_k': nrm((N_EVEN, B_WIDTH), 0.1),
        'rwkv_gn_w': 1.0 + nrm((N_EVEN, B_WIDTH), 0.02),
        'rwkv_gn_b': nrm((N_EVEN, B_WIDTH), 0.02),
        'gm_w_in': nrm((N_ODD, D, 3 * C_WIDTH), D ** -0.5),
        'gm_ln_g': 1.0 + nrm((N_ODD, C_WIDTH), 0.02),
        'gm_ln_b': nrm((N_ODD, C_WIDTH), 0.02),
        'gm_w_s': nrm((N_ODD, C_GROUPS, C_CHUNK, C_CHUNK), C_CHUNK ** -0.5),
        'gm_b_s': 1.0 + nrm((N_ODD, C_GROUPS, C_CHUNK), 0.02),
        'gm_w_out': nrm((N_ODD, C_WIDTH, D), C_WIDTH ** -0.5),
        'final_g': 1.0 + nrm((D,), 0.02),
    }


def reference(x, c, ctx, c_ctx, mod_w, mod_b, norm_g, ab_w_in, ab_w_out, attn_sink, rwkv_conv,
              rwkv_w0, rwkv_w2, rwkv_a0, rwkv_a2, rwkv_k_k, rwkv_k_a, rwkv_r_k, rwkv_gn_w, rwkv_gn_b,
              gm_w_in, gm_ln_g, gm_ln_b, gm_w_s, gm_b_s, gm_w_out, final_g):
    n_lat = x.shape[1]
    ang_row, ang_col = axial_rope_angles(n_lat)
    cond_lat = jax.nn.silu(c)[:, None, :]
    cond_ctx = jax.nn.silu(c_ctx)
    for l in range(DEPTH):
        i = l // 2
        ctx_read_later = any(j % 2 == 0 for j in range(l + 1, DEPTH))
        shift, scale, gate = jnp.split(cond_lat @ mod_w[l] + mod_b[l], 3, axis=-1)
        h = rms_norm(x, norm_g[l]) * (1.0 + scale) + shift
        if l % 2 == 0 or ctx_read_later:
            shift_c, scale_c, gate_c = jnp.split(cond_ctx @ mod_w[l] + mod_b[l], 3, axis=-1)
            h_c = rms_norm(ctx, norm_g[l]) * (1.0 + scale_c) + shift_c
        if l % 2 == 0:
            y, y_c = ab_mixer(h, h_c, ang_row, ang_col, ab_w_in[i], ab_w_out[i], attn_sink[i],
                              rwkv_conv[i], rwkv_w0[i], rwkv_w2[i], rwkv_a0[i], rwkv_a2[i],
                              rwkv_k_k[i], rwkv_k_a[i], rwkv_r_k[i], rwkv_gn_w[i], rwkv_gn_b[i],
                              ctx_read_later)
        else:
            y = gmlp_branch(h, gm_w_in[i], gm_ln_g[i], gm_ln_b[i], gm_w_s[i], gm_b_s[i], gm_w_out[i])
            y_c = (gmlp_branch(h_c, gm_w_in[i], gm_ln_g[i], gm_ln_b[i], gm_w_s[i], gm_b_s[i], gm_w_out[i])
                   if ctx_read_later else None)
        x = x + gate * y
        if ctx_read_later:
            ctx = ctx + gate_c * y_c
    return rms_norm(x, final_g)
```

```cpp
#include <hip/hip_runtime.h>
#include <cstdio>
#include <cstdint>

#ifndef MK_N_LAUNCHES
#define MK_N_LAUNCHES 14
#endif

namespace pg8 {
#define PG8_LAS __attribute__((address_space(3)))
typedef unsigned short bf16_t;
typedef short bf16x8 __attribute__((ext_vector_type(8)));
typedef float f32x4 __attribute__((ext_vector_type(4)));
typedef unsigned u32x4 __attribute__((ext_vector_type(4)));
constexpr int BM = 256, BK = 64, HALF = 128, HTB = HALF * BK * 2, STAGE_BYTES = 8 * HTB, NXCD = 8, WGM = 8;

__host__ __device__ __forceinline__ int lds_byte(int r, int c) { const int st = (r >> 4) * 2 + (c >> 5), rr = r & 15, cc = c & 31, ob = rr * 64 + cc * 2; return st * 1024 + (ob ^ (((ob >> 9) & 1) << 5)); }
__host__ __device__ __forceinline__ void stage_rc(int b, int& R, int& C) { const int st = b / 1024, sb = b % 1024, swz = sb ^ (((sb >> 9) & 1) << 5); R = (st >> 1) * 16 + swz / 64; C = (st & 1) * 32 + (swz % 64) / 2; }
__host__ __device__ __forceinline__ int perm32(int rho) { const int n = rho >> 4, i = rho & 15; return 8 * (i >> 2) + 4 * n + (i & 3); }

struct Unit { int pm, pn; };
struct Gemm { const bf16_t* A; const bf16_t* Bt; int M, N, K, lda; };

struct StaticOrder {
    int nM, nN, nwg, G, c;
    __host__ __device__ void init(int M, int N, int G_, int c_) { nM = M / BM; nN = N / BM; nwg = nM * nN; G = G_; c = c_; }
    __host__ __device__ bool next(int i, Unit& u) const {
        const long L = (long)i * G + c; if (L >= nwg) return false;
        int wgid = (int)L; { const int q = nwg / NXCD, r = nwg % NXCD, xcd = wgid % NXCD, off = wgid / NXCD; wgid = (xcd < r ? xcd * (q + 1) : r * (q + 1) + (xcd - r) * q) + off; }
        const int nig = WGM * nN, gid = wgid / nig, fm = gid * WGM, gsz = (nM - fm) < WGM ? (nM - fm) : WGM;
        u.pm = fm + ((wgid % nig) % gsz); u.pn = (wgid % nig) / gsz; return true;
    }
    __device__ __forceinline__ void a_ready(const Unit&) const {}
    __device__ __forceinline__ void done(const Unit&) const {}
};

__device__ __forceinline__ unsigned cvt_pk_bf16(float lo, float hi) { unsigned r; asm volatile("v_cvt_pk_bf16_f32 %0, %1, %2" : "=v"(r) : "v"(lo), "v"(hi)); return r; }

template <class Epi, class Sched, bool ALIGN_EPI = false, bool SP2 = false>
__device__ __forceinline__ void gemm_phase(PG8_LAS unsigned char* lds, const Gemm g, const Sched& S, const Epi& E) {
    int tid = threadIdx.x; asm volatile("" : "+v"(tid)); const int wid = __builtin_amdgcn_readfirstlane(tid >> 6), lane = tid & 63, wr = wid >> 2, wc = wid & 3, fr = lane & 15, fq = lane >> 4;
    const int K = g.K, nt = K / BK, lda = g.lda;
    unsigned voffA[2], voffB[2];
#pragma unroll
    for (int i = 0; i < 2; ++i) { int R, C; stage_rc(tid * 16 + i * 8192, R, C); const int Rb = Epi::PERM ? ((R & ~31) + perm32(R & 31)) : R;
        voffA[i] = (unsigned)(R * lda + C) * 2u; voffB[i] = (unsigned)(Rb * K + C) * 2u; }
    const size_t kstep = (size_t)(BK * 2);
    const size_t hstepA = (size_t)HALF * lda * 2, hstepB = (size_t)HALF * K * 2;
    const size_t tstepA = 2 * hstepA, tstepB = 2 * hstepB;
    const unsigned ldsw = (unsigned)wid * 1024u;
    const int aoff = lds_byte(wr * 64 + fr, fq * 8), boff = lds_byte(wc * 32 + fr, fq * 8);
#define PG8_SA(b, h) (((b) * 2 + (h)) * HTB)
#define PG8_SB(b, h) ((4 + (b) * 2 + (h)) * HTB)
#define PG8_STAGE(bufoff, gbase, voff) do { _Pragma("unroll") for (int _i = 0; _i < 2; ++_i) \
        __builtin_amdgcn_global_load_lds((const unsigned*)((const char*)(gbase) + (voff)[_i]), (PG8_LAS unsigned*)(lds + (bufoff) + ldsw + _i * 8192), 16, 0, 0); } while (0)
#define PG8_LDA(dst, b, h) do { _Pragma("unroll") for (int m = 0; m < 4; ++m) _Pragma("unroll") for (int k = 0; k < 2; ++k) dst[m][k] = *(const PG8_LAS bf16x8*)(lds + PG8_SA(b, h) + aoff + m * 2048 + k * 1024); } while (0)
#define PG8_LDB(dst, b, h) do { _Pragma("unroll") for (int n = 0; n < 2; ++n) _Pragma("unroll") for (int k = 0; k < 2; ++k) dst[n][k] = *(const PG8_LAS bf16x8*)(lds + PG8_SB(b, h) + boff + n * 2048 + k * 1024); } while (0)
#define PG8_MMA(ai, bj, At, Bt) do { __builtin_amdgcn_s_setprio(1); _Pragma("unroll") for (int m = 0; m < 4; ++m) _Pragma("unroll") for (int n = 0; n < 2; ++n) _Pragma("unroll") for (int k = 0; k < 2; ++k) \
        acc[ai][bj][m][n] = __builtin_amdgcn_mfma_f32_16x16x32_bf16(Bt[n][k], At[m][k], acc[ai][bj][m][n], 0, 0, 0); __builtin_amdgcn_s_setprio(0); } while (0)
#define PG8_WAIT_V(n) asm volatile("s_waitcnt vmcnt(" #n ")" ::: "memory")
#define PG8_WAIT_L(n) asm volatile("s_waitcnt lgkmcnt(" #n ")" ::: "memory")
#define PG8_BAR __builtin_amdgcn_s_barrier()
#define PG8_SCHED __builtin_amdgcn_sched_barrier(0)
    Unit cur, nxt; int ui = 0;
    if (!S.next(0, cur)) return;
    f32x4 acc[2][2][4][2];
#pragma unroll
    for (int a = 0; a < 2; ++a)
#pragma unroll
        for (int b = 0; b < 2; ++b)
#pragma unroll
            for (int m = 0; m < 4; ++m)
#pragma unroll
                for (int n = 0; n < 2; ++n) acc[a][b][m][n] = (f32x4){0.f, 0.f, 0.f, 0.f};
    bf16x8 At[4][2], B0[2][2], B1[2][2];
    const char* cA = (const char*)g.A + (size_t)cur.pm * tstepA; const char* cB = (const char*)g.Bt + (size_t)cur.pn * tstepB;
    S.a_ready(cur);
    if constexpr (SP2) {
        PG8_STAGE(PG8_SB(0, 0), cB, voffB); PG8_STAGE(PG8_SB(0, 1), cB + hstepB, voffB); PG8_STAGE(PG8_SA(0, 0), cA, voffA); PG8_STAGE(PG8_SA(0, 1), cA + hstepA, voffA);
        if (wr == 1) PG8_BAR;
        PG8_WAIT_V(2); PG8_BAR;
        PG8_STAGE(PG8_SB(1, 0), cB + kstep, voffB); PG8_STAGE(PG8_SA(1, 0), cA + kstep, voffA); PG8_STAGE(PG8_SB(1, 1), cB + hstepB + kstep, voffB);
        PG8_WAIT_V(6); PG8_BAR;
    } else {
        PG8_STAGE(PG8_SB(0, 0), cB, voffB); PG8_STAGE(PG8_SA(0, 0), cA, voffA); PG8_STAGE(PG8_SB(0, 1), cB + hstepB, voffB); PG8_STAGE(PG8_SA(0, 1), cA + hstepA, voffA);
        if (wr == 1) PG8_BAR;
        PG8_WAIT_V(4); PG8_BAR;
        PG8_STAGE(PG8_SB(1, 0), cB + kstep, voffB); PG8_STAGE(PG8_SA(1, 0), cA + kstep, voffA); PG8_STAGE(PG8_SB(1, 1), cB + hstepB + kstep, voffB);
        PG8_WAIT_V(6); PG8_BAR;
    }
    for (;;) {
        const bool has_next = S.next(ui + 1, nxt);
        const char* nA = has_next ? (const char*)g.A + (size_t)nxt.pm * tstepA : cA; const char* nB = has_next ? (const char*)g.Bt + (size_t)nxt.pn * tstepB : cB;
#pragma clang loop unroll(disable)
        for (int t = 0; t < nt; t += 2) {
            const bool last = (t == nt - 2);
            const char* a1 = cA + (size_t)(t + 1) * kstep;
            const char* a2 = last ? nA : cA + (size_t)(t + 2) * kstep; const char* b2 = last ? nB : cB + (size_t)(t + 2) * kstep;
            const char* a3 = a2 + kstep; const char* b3 = b2 + kstep;
            if (last && has_next) S.a_ready(nxt);
            if constexpr (SP2) {
            PG8_LDB(B0, 0, 0); PG8_LDB(B1, 0, 1); PG8_SCHED; PG8_LDA(At, 0, 0); PG8_STAGE(PG8_SA(1, 1), a1 + hstepA, voffA);
            PG8_WAIT_V(8); PG8_WAIT_L(0); PG8_BAR; PG8_MMA(0, 0, At, B0); PG8_MMA(0, 1, At, B1); PG8_BAR; PG8_SCHED;
            PG8_LDA(At, 0, 1); PG8_STAGE(PG8_SB(0, 0), b2, voffB); PG8_STAGE(PG8_SB(0, 1), b2 + hstepB, voffB); PG8_STAGE(PG8_SA(0, 0), a2, voffA);
            PG8_WAIT_V(8); PG8_WAIT_L(0); PG8_BAR; PG8_MMA(1, 0, At, B0); PG8_MMA(1, 1, At, B1); PG8_BAR; PG8_SCHED;
            PG8_LDB(B0, 1, 0); PG8_LDB(B1, 1, 1); PG8_SCHED; PG8_LDA(At, 1, 0); PG8_STAGE(PG8_SA(0, 1), a2 + hstepA, voffA);
            PG8_WAIT_V(8); PG8_WAIT_L(0); PG8_BAR; PG8_MMA(0, 0, At, B0); PG8_MMA(0, 1, At, B1); PG8_BAR; PG8_SCHED;
            PG8_LDA(At, 1, 1); PG8_STAGE(PG8_SB(1, 0), b3, voffB); PG8_STAGE(PG8_SB(1, 1), b3 + hstepB, voffB); PG8_STAGE(PG8_SA(1, 0), a3, voffA);
            PG8_WAIT_V(8); PG8_WAIT_L(0); PG8_BAR; PG8_MMA(1, 0, At, B0); PG8_MMA(1, 1, At, B1); PG8_BAR; PG8_SCHED;
            } else {
            PG8_LDB(B0, 0, 0); PG8_SCHED; PG8_LDA(At, 0, 0); PG8_STAGE(PG8_SA(1, 1), a1 + hstepA, voffA);
            PG8_WAIT_L(8); PG8_BAR; PG8_WAIT_L(0); PG8_MMA(0, 0, At, B0); PG8_BAR; PG8_SCHED;
            PG8_LDB(B1, 0, 1); PG8_STAGE(PG8_SB(0, 0), b2, voffB);
            PG8_BAR; PG8_WAIT_L(0); PG8_MMA(0, 1, At, B1); PG8_BAR;
            PG8_LDA(At, 0, 1); PG8_STAGE(PG8_SA(0, 0), a2, voffA);
            PG8_BAR; PG8_WAIT_L(0); PG8_MMA(1, 0, At, B0); PG8_BAR; PG8_SCHED;
            PG8_STAGE(PG8_SB(0, 1), b2 + hstepB, voffB);
            PG8_WAIT_V(6); PG8_BAR; PG8_MMA(1, 1, At, B1); PG8_BAR;
            PG8_LDB(B0, 1, 0); PG8_SCHED; PG8_LDA(At, 1, 0); PG8_STAGE(PG8_SA(0, 1), a2 + hstepA, voffA);
            PG8_WAIT_L(8); PG8_BAR; PG8_WAIT_L(0); PG8_MMA(0, 0, At, B0); PG8_BAR; PG8_SCHED;
            PG8_LDB(B1, 1, 1); PG8_STAGE(PG8_SB(1, 0), b3, voffB);
            PG8_BAR; PG8_WAIT_L(0); PG8_MMA(0, 1, At, B1); PG8_BAR;
            PG8_LDA(At, 1, 1); PG8_STAGE(PG8_SA(1, 0), a3, voffA);
            PG8_BAR; PG8_WAIT_L(0); PG8_MMA(1, 0, At, B0); PG8_BAR; PG8_SCHED;
            PG8_STAGE(PG8_SB(1, 1), b3 + hstepB, voffB);
            PG8_WAIT_V(6); PG8_BAR; PG8_MMA(1, 1, At, B1); PG8_BAR;
            }
        }
        if constexpr (ALIGN_EPI) { if (wr == 0) PG8_BAR; }
        E(acc, cur, wr, wc, fr, fq);
        if (!has_next) break;
#pragma unroll
        for (int a = 0; a < 2; ++a)
#pragma unroll
            for (int b = 0; b < 2; ++b)
#pragma unroll
                for (int m = 0; m < 4; ++m)
#pragma unroll
                    for (int n = 0; n < 2; ++n) acc[a][b][m][n] = (f32x4){0.f, 0.f, 0.f, 0.f};
        cur = nxt; cA = nA; cB = nB; ++ui;
        if constexpr (ALIGN_EPI) { if (wr == 1) PG8_BAR; }
    }
    PG8_WAIT_V(0);
    if constexpr (!ALIGN_EPI) { if (wr == 0) PG8_BAR; }
    PG8_BAR;
#undef PG8_SA
#undef PG8_SB
#undef PG8_STAGE
#undef PG8_LDA
#undef PG8_LDB
#undef PG8_MMA
#undef PG8_WAIT_V
#undef PG8_WAIT_L
#undef PG8_BAR
#undef PG8_SCHED
}
}

#define GAS __attribute__((address_space(1)))
#define LAS __attribute__((address_space(3)))
typedef unsigned short bf16;
typedef unsigned v4u __attribute__((ext_vector_type(4)));
typedef unsigned v2u __attribute__((ext_vector_type(2)));
typedef float f32x4 __attribute__((ext_vector_type(4)));
typedef float f32x2 __attribute__((ext_vector_type(2)));
typedef short bf16x8 __attribute__((ext_vector_type(8)));
#define LDS_WAIT() asm volatile("s_waitcnt lgkmcnt(0)" ::: "memory")
#define VM_WAIT() asm volatile("s_waitcnt vmcnt(0)" ::: "memory")

__device__ __forceinline__ unsigned f2bf(float f) { unsigned u = __builtin_bit_cast(unsigned, f); return (u + 0x7fffu + ((u >> 16) & 1u)) >> 16; }
__device__ __forceinline__ unsigned pk2(float lo, float hi) { return pg8::cvt_pk_bf16(lo, hi); }
__device__ __forceinline__ float bflo(unsigned w) { return __builtin_bit_cast(float, w << 16); }
__device__ __forceinline__ float bfhi(unsigned w) { return __builtin_bit_cast(float, w & 0xffff0000u); }
__device__ __forceinline__ void unpack8(const v4u w, float (&f)[8]) { f[0] = bflo(w.x); f[1] = bfhi(w.x); f[2] = bflo(w.y); f[3] = bfhi(w.y); f[4] = bflo(w.z); f[5] = bfhi(w.z); f[6] = bflo(w.w); f[7] = bfhi(w.w); }
__device__ __forceinline__ v4u pack8(const float (&f)[8]) { v4u w; w.x = pk2(f[0], f[1]); w.y = pk2(f[2], f[3]); w.z = pk2(f[4], f[5]); w.w = pk2(f[6], f[7]); return w; }
__device__ __forceinline__ float fexp2(float x) { return __builtin_amdgcn_exp2f(x); }
__device__ __forceinline__ float fexp(float x) { return __builtin_amdgcn_exp2f(x * 1.4426950408889634f); }
__device__ __forceinline__ float frcp(float x) { return __builtin_amdgcn_rcpf(x); }
__device__ __forceinline__ float sigmoidf_(float x) { return frcp(1.0f + fexp(-x)); }
__device__ __forceinline__ float siluf_(float x) { return x * sigmoidf_(x); }
__device__ __forceinline__ float tanhf_(float x) { return 1.0f - 2.0f * frcp(1.0f + fexp(2.0f * x)); }
__device__ __forceinline__ float gelu_tanh(float x) { const float u = 1.5957691216057308f * (x + 0.044715f * x * x * x); return x * sigmoidf_(u); }
__device__ __forceinline__ float wave_sum(float v) {
#pragma unroll
    for (int o = 1; o < 64; o <<= 1) v += __shfl_xor(v, o);
    return v;
}
__device__ __forceinline__ int my_tid() { int t = threadIdx.x; asm volatile("" : "+v"(t)); return t; }
__device__ __forceinline__ float dpp_f(float x, const int ctrl_sel) {
    const int xi = __builtin_bit_cast(int, x); int r;
    if (ctrl_sel == 0) r = __builtin_amdgcn_update_dpp(xi, xi, 0xB1, 0xF, 0xF, false);
    else if (ctrl_sel == 1) r = __builtin_amdgcn_update_dpp(xi, xi, 0x4E, 0xF, 0xF, false);
    else r = __builtin_amdgcn_update_dpp(xi, xi, 0x141, 0xF, 0xF, false);
    return __builtin_bit_cast(float, r);
}
__device__ __forceinline__ float sum8(float x) { x += dpp_f(x, 0); x += dpp_f(x, 1); x += dpp_f(x, 2); return x; }

#define XB_TMO      128
#define XB_XCNT(j)  (256  + 64 * (j))
#define XB_XSUB(j)  (1280 + 64 * (j))
#define XB_XGEN(j)  (2304 + 64 * (j))
#define XB_TOP      3328
#define XB_TOPGEN   3392
#define XCD_BAR_WORDS 3456
#define XB_SPIN_CAP (1u << 18)

__device__ __forceinline__ unsigned xb_ld(unsigned* p)              { return __hip_atomic_load(p, __ATOMIC_RELAXED, __HIP_MEMORY_SCOPE_AGENT); }
__device__ __forceinline__ unsigned xb_add(unsigned* p, unsigned v) { return __hip_atomic_fetch_add(p, v, __ATOMIC_RELAXED, __HIP_MEMORY_SCOPE_AGENT); }
__device__ __forceinline__ unsigned xb_xcc_id() { return (unsigned)__builtin_amdgcn_s_getreg((3 << 11) | 20) & 0xFu; }
#define XB_SPIN(cond, bar) do { unsigned _sp = 0; while (cond) { __builtin_amdgcn_s_sleep(1); \
    if ((++_sp & 255u) == 0u) { if (xb_ld(&(bar)[XB_TMO])) break; if (_sp > XB_SPIN_CAP) { atomicAdd(&(bar)[XB_TMO], 1u); break; } } } } while (0)

struct XcdBarrier {
    unsigned* bar; unsigned x;
    volatile LAS unsigned* st;
};
__device__ __forceinline__ XcdBarrier xcd_barrier_post(unsigned* bar, volatile LAS unsigned* st) {
    XcdBarrier b; b.bar = bar; b.x = xb_xcc_id(); b.st = st;
    if (threadIdx.x == 0) (void)xb_add(&bar[XB_XCNT(b.x)], 1u);
    return b;
}
__device__ __forceinline__ void xcd_barrier_complete(unsigned* bar, unsigned x, unsigned& nloc, unsigned& nx) {
    const unsigned G = gridDim.x * gridDim.y * gridDim.z;
    unsigned sum, cnt, mine, sp = 0u;
    for (;;) {
        sum = 0u; cnt = 0u; mine = 0u;
#pragma unroll
        for (unsigned j = 0; j < 16; ++j) { const unsigned c = xb_ld(&bar[XB_XCNT(j)]); sum += c; cnt += (c > 0u) ? 1u : 0u; mine = (j == x) ? c : mine; }
        if (sum == G) break;
        __builtin_amdgcn_s_sleep(1);
        if ((++sp & 255u) == 0u) { if (xb_ld(&bar[XB_TMO])) break; if (sp > XB_SPIN_CAP) { atomicAdd(&bar[XB_TMO], 1u); break; } }
    }
    nloc = mine > 0u ? mine : 1u; nx = cnt > 0u ? cnt : 1u;
}
__device__ __forceinline__ void xcd_barrier(const XcdBarrier& b) {
    asm volatile("s_waitcnt vmcnt(0)" ::: "memory");
    __syncthreads();
    if (threadIdx.x == 0) {
        unsigned* bar = b.bar;
        __builtin_amdgcn_s_waitcnt(0);
        unsigned nloc = b.st[0], nx = b.st[1];
        if (nloc == 0u) { xcd_barrier_complete(bar, b.x, nloc, nx); b.st[0] = nloc; b.st[1] = nx; }
        const unsigned old = xb_add(&bar[XB_XSUB(b.x)], 1u);
        const unsigned gen = old / nloc;
        if (old + 1u == (gen + 1u) * nloc) {
            __builtin_amdgcn_fence(__ATOMIC_RELEASE, "agent");
            asm volatile("s_waitcnt vmcnt(0)" ::: "memory");
            const unsigned og = xb_add(&bar[XB_TOP], 1u);
            const unsigned tg = og / nx;
            if (og + 1u == (tg + 1u) * nx) xb_add(&bar[XB_TOPGEN], 1u);
            else XB_SPIN(xb_ld(&bar[XB_TOPGEN]) == tg, bar);
            __builtin_amdgcn_fence(__ATOMIC_ACQUIRE, "agent");
            xb_add(&bar[XB_XGEN(b.x)], 1u);
            asm volatile("s_waitcnt vmcnt(0)" ::: "memory");
        } else {
            XB_SPIN(xb_ld(&bar[XB_XGEN(b.x)]) == gen, bar);
            __builtin_amdgcn_fence(__ATOMIC_ACQUIRE, "agent");
            asm volatile("s_waitcnt vmcnt(0)" ::: "memory");
        }
    }
    __syncthreads();
}

constexpr int NWAVES = 8, NTHREADS = 512;
constexpr int D = 4096, BATCH = 2, SEQ = 8192, CTXL = 256;
constexpr int MLAT = BATCH * SEQ;
constexpr int MCTX = BATCH * CTXL;
constexpr int MALL = MLAT + MCTX;
constexpr int AB_IN = 13696, ZLD = 13824;
constexpr int ZQ = 0, ZK = 2048, ZV = 2560, ZGA = 3072, ZR = 5120, ZKB = 7168, ZVB = 9216, ZGB = 11264, ZDL = 13312, ZAL = 13504;
constexpr int BW = 2048;
constexpr int CW = 12288;
constexpr int VTLD = SEQ + CTXL;
constexpr int NPHASE = 14;

constexpr size_t MiB = 1u << 20;
constexpr size_t WS_CTL   = 0;
constexpr size_t CTL_ZERO_BYTES = 1 * MiB;
constexpr size_t WS_MODV  = 1 * MiB;
constexpr size_t WS_ROPE  = WS_MODV + 512 * 1024;
constexpr size_t WS_STATS = WS_ROPE + 64 * 1024;
constexpr size_t WS_WSB   = 2 * MiB;
constexpr size_t WS_WLORA = 3 * MiB;
constexpr size_t WS_WOUT0 = 9 * MiB;
constexpr size_t WS_WGOUT = 41 * MiB;
constexpr size_t WS_WGIN  = 137 * MiB;
constexpr size_t WS_H     = 425 * MiB;
constexpr size_t WS_YS    = WS_H;
constexpr size_t WS_X1    = 557 * MiB;
constexpr size_t WS_OAB   = 813 * MiB;
constexpr size_t WS_WIN0  = 941 * MiB;
constexpr size_t WS_VTA   = 1049 * MiB;
constexpr size_t WS_Z     = 1066 * MiB;
constexpr size_t WS_RKVK  = 1512 * MiB;
constexpr size_t WS_EKK   = 1776 * MiB;
constexpr size_t WS_END   = 2172 * MiB;
constexpr size_t WS_VT    = WS_Z;
constexpr size_t WS_STATP = WS_RKVK;
constexpr size_t WS_Y     = WS_EKK;
static_assert(WS_WLORA + (size_t)8192 * 384 * 2 <= WS_WOUT0 && WS_WOUT0 + (size_t)D * D * 2 <= WS_WGOUT && WS_WGOUT + (size_t)D * CW * 2 <= WS_WGIN && WS_WGIN + (size_t)3 * CW * D * 2 <= WS_H, "ws map 1");
static_assert(WS_H + (size_t)MALL * D * 2 <= WS_X1 && WS_X1 + (size_t)MLAT * D * 4 <= WS_OAB && WS_OAB + (size_t)MLAT * D * 2 <= WS_WIN0 && WS_WIN0 + (size_t)ZLD * D * 2 <= WS_VTA, "ws map 2");
static_assert(WS_VTA + (size_t)2 * 4 * 128 * VTLD * 2 <= WS_Z && WS_Z + (size_t)MALL * ZLD * 2 <= WS_RKVK && WS_RKVK + (size_t)4 * MALL * BW * 2 <= WS_EKK && WS_EKK + (size_t)6 * MALL * BW * 2 <= WS_END, "ws map 3");
static_assert(WS_VT + (size_t)CW * MLAT * 2 <= WS_RKVK && WS_STATP + (size_t)MLAT * 192 * 8 <= WS_EKK && WS_Y + (size_t)MLAT * CW * 2 <= WS_END && WS_END <= (size_t)2304 * MiB, "ws map 4");
constexpr int CW_BAR = 4096;

constexpr int RING_BYTES = 131072;
constexpr int LDSCTL_OFF = RING_BYTES;
constexpr int LDS_BYTES = 147456;

struct Args { const float* in[27]; float* out; unsigned char* ws; int ph_lo, ph_hi; };

enum { I_X = 0, I_C, I_CTX, I_CCTX, I_MODW, I_MODB, I_NORMG, I_WIN, I_WOUT, I_SINK, I_CONV, I_W0, I_W2, I_A0, I_A2, I_KK, I_KA, I_RK, I_GNW, I_GNB,
       I_GWIN, I_LNG, I_LNB, I_WS, I_BS, I_GWOUT, I_FING };

__device__ __forceinline__ int src_col(int mat, int c) {
    if (mat == 0) {
        if (c >= AB_IN) return -1;
        if (c < ZV) { const int head = c >> 7, p = c & 127, qq = 4 * (p >> 3) + (p & 3), n = (p >> 2) & 1; return (head << 7) + qq + (qq >= 32 ? 32 : 0) + 32 * n; }
        return c;
    }
    if (mat == 2) {
        if (c < CW) return CW + c;
        const int cc = c - CW, tile = cc >> 8, w = cc & 255;
        return w < 128 ? (tile * 128 + w) : (2 * CW + tile * 128 + (w - 128));
    }
    return c;
}
__device__ __forceinline__ void p0_transpose_item(const float* W, int K, int N, bf16* WT, int mat, LAS float* scr, int item, int lane, int nblk) {
    const int kb = item / nblk, nb = item % nblk, k0 = 64 * kb, n0 = 32 * nb;
    const int sc = src_col(mat, n0 + (lane & 31));
#pragma unroll 8
    for (int i = 0; i < 32; ++i) { const int kk = 2 * i + (lane >> 5); scr[kk * 33 + (lane & 31)] = sc >= 0 ? W[(size_t)(k0 + kk) * N + sc] : 0.f; }
    LDS_WAIT(); asm volatile("" ::: "memory");
    const int c = lane & 7;
#pragma unroll
    for (int j = 0; j < 4; ++j) { const int n = (lane >> 3) + 8 * j; const LAS float* s = scr + (8 * c) * 33 + n;
        v4u o; o.x = pk2(s[0 * 33], s[1 * 33]); o.y = pk2(s[2 * 33], s[3 * 33]); o.z = pk2(s[4 * 33], s[5 * 33]); o.w = pk2(s[6 * 33], s[7 * 33]);
        *(GAS v4u*)(WT + (size_t)(n0 + n) * K + k0 + 8 * c) = o; }
    LDS_WAIT(); asm volatile("" ::: "memory");
}

__device__ __forceinline__ void p0_phase(const Args& a, LAS unsigned char* lds) {
    const int tid = my_tid(), lane = tid & 63, wave = __builtin_amdgcn_readfirstlane(tid >> 6);
    unsigned char* ws = a.ws;
    const int G = gridDim.x, bx = blockIdx.x;
    {
        LAS float* sc = (LAS float*)lds;
        LAS float* red = (LAS float*)(lds + 49152);
        for (int i = tid; i < 3 * D; i += NTHREADS) { const int j = i / D, k = i % D; const float v = j < 2 ? a.in[I_C][j * D + k] : a.in[I_CCTX][k]; sc[i] = siluf_(v); }
        __syncthreads();
        float* modv = (float*)(ws + WS_MODV);
        for (int item = bx; item < 256; item += G) {
            const int l = item >> 7, cb = (item & 127) * 96;
            const float* W = a.in[I_MODW] + (size_t)l * D * 3 * D;
            if (tid < 384) {
                const int cg = tid % 24, ks = tid / 24;
                f32x4 a0 = {0.f, 0.f, 0.f, 0.f}, a1 = a0, a2 = a0;
                const float* wp = W + (size_t)(ks * 256) * (3 * D) + cb + 4 * cg;
#pragma unroll 8
                for (int r = 0; r < 256; ++r) {
                    const f32x4 w = *(const GAS f32x4*)(wp + (size_t)r * (3 * D));
                    const int k = ks * 256 + r;
                    a0 += w * sc[k]; a1 += w * sc[D + k]; a2 += w * sc[2 * D + k];
                }
                LAS float* rp = red + (ks * 24 + cg) * 12;
                *(LAS f32x4*)(rp) = a0; *(LAS f32x4*)(rp + 4) = a1; *(LAS f32x4*)(rp + 8) = a2;
            }
            __syncthreads();
            if (tid < 288) {
                const int j = tid / 96, col = tid % 96, cg = col >> 2, e = col & 3;
                float s = 0.f;
#pragma unroll
                for (int ks = 0; ks < 16; ++ks) s += red[(ks * 24 + cg) * 12 + j * 4 + e];
                modv[((size_t)l * 3 + j) * (3 * D) + cb + col] = s + a.in[I_MODB][(size_t)l * 3 * D + cb + col];
            }
            __syncthreads();
        }
    }
    {
        LAS float* scr = (LAS float*)(lds + wave * 16384);
        const int gw = bx * NWAVES + wave, NGW = G * NWAVES;
        constexpr int NB0 = ZLD / 32, NB1 = D / 32, NB2 = 3 * CW / 32, NB3 = D / 32;
        constexpr int I0 = (D / 64) * NB0, I1 = (D / 64) * NB1, I2 = (D / 64) * NB2, I3 = (CW / 64) * NB3;
        for (int it = gw; it < I0 + I1 + I2 + I3; it += NGW) {
            int r = it;
            if (r < I0) { p0_transpose_item(a.in[I_WIN], D, AB_IN, (bf16*)(ws + WS_WIN0), 0, scr, r, lane, NB0); continue; } r -= I0;
            if (r < I1) { p0_transpose_item(a.in[I_WOUT], D, D, (bf16*)(ws + WS_WOUT0), 1, scr, r, lane, NB1); continue; } r -= I1;
            if (r < I2) { p0_transpose_item(a.in[I_GWIN], D, 3 * CW, (bf16*)(ws + WS_WGIN), 2, scr, r, lane, NB2); continue; } r -= I2;
            p0_transpose_item(a.in[I_GWOUT], CW, D, (bf16*)(ws + WS_WGOUT), 3, scr, r, lane, NB3);
        }
    }
    {
        const size_t gt = (size_t)bx * NTHREADS + tid, GT = (size_t)G * NTHREADS;
        bf16* wl = (bf16*)(ws + WS_WLORA);
        for (size_t i = gt; i < (size_t)8192 * 384; i += GT) {
            const int n = (int)(i / 384), k = (int)(i % 384), kind = n >> 11, c = n & 2047;
            float v = 0.f;
            if (k >= kind * 96 && k < kind * 96 + 96) { const int r = k - kind * 96, dir = kind & 1; const float* src = (kind < 2) ? a.in[I_W2] : a.in[I_A2]; v = src[((size_t)dir * 96 + r) * BW + c]; }
            wl[i] = (bf16)f2bf(v);
        }
        bf16* wsb = (bf16*)(ws + WS_WSB);
        for (size_t i = gt; i < (size_t)16 * 128 * 128; i += GT) wsb[i] = (bf16)f2bf(a.in[I_WS][i]);
        float* rope = (float*)(ws + WS_ROPE);
        for (size_t i = gt; i < (size_t)128 * 32; i += GT) {
            const int pos = (int)(i >> 5), f = (int)(i & 31);
            const float inv = powf(10000.0f, -(float)f / 32.0f); const float ang = (float)pos * inv;
            rope[i] = cosf(ang); rope[4096 + i] = sinf(ang);
        }
    }
}

__device__ __forceinline__ void norm_phase(const Args& a, LAS unsigned char* lds, int layer, const float* xlat, const float* xctx, int nrows) {
    const int tid = my_tid(), lane = tid & 63, wave = __builtin_amdgcn_readfirstlane(tid >> 6);
    LAS float* gs = (LAS float*)lds; LAS float* sh = (LAS float*)(lds + 49152);
    const float* modv = (const float*)(a.ws + WS_MODV) + (size_t)layer * 3 * 3 * D;
    const float* g = a.in[I_NORMG] + (size_t)layer * D;
    for (int i = tid; i < 3 * D; i += NTHREADS) { const int j = i / D, k = i % D; gs[i] = g[k] * (1.0f + modv[(size_t)j * 3 * D + D + k]); sh[i] = modv[(size_t)j * 3 * D + k]; }
    __syncthreads();
    bf16* H = (bf16*)(a.ws + WS_H);
    const int gw = blockIdx.x * NWAVES + wave, NGW = gridDim.x * NWAVES;
    for (int row = gw; row < nrows; row += NGW) {
        const float* xr; int j;
        if (row < MLAT) { xr = xlat + (size_t)row * D; j = row >> 13; } else { xr = xctx + (size_t)(row - MLAT) * D; j = 2; }
        const GAS f32x4* xp = (const GAS f32x4*)xr + lane;
        f32x4 v[16]; float s = 0.f;
#pragma unroll
        for (int q = 0; q < 16; ++q) { v[q] = xp[64 * q]; s += (v[q].x * v[q].x + v[q].y * v[q].y) + (v[q].z * v[q].z + v[q].w * v[q].w); }
        const float rstd = 1.0f / sqrtf(wave_sum(s) * (1.0f / D) + 1e-6f);
        GAS v2u* op = (GAS v2u*)(H + (size_t)row * D) + lane;
#pragma unroll
        for (int q = 0; q < 16; ++q) {
            const int c = 4 * lane + 256 * q;
            const f32x4 gg = *(const LAS f32x4*)(gs + j * D + c), ss = *(const LAS f32x4*)(sh + j * D + c);
            const f32x4 o = v[q] * rstd * gg + ss;
            v2u w; w.x = pk2(o.x, o.y); w.y = pk2(o.z, o.w); op[64 * q] = w;
        }
    }
}

typedef pg8::f32x4 af4;
struct EpiZ {
    static constexpr bool PERM = true;
    bf16* Z; bf16* VTA; const float* rope;
    __device__ __forceinline__ void operator()(const af4 (&acc)[2][2][4][2], const pg8::Unit& u, int wr, int wc, int fr, int fq) const {
        const int pn = u.pn, row0 = u.pm * 256 + wr * 64 + fr, col0 = pn * 256 + wc * 32 + 8 * fq;
        if (pn < 10 && u.pm < 64) {
            const float qs = (pn < 8) ? 0.08838834764831845f * 1.4426950408889634f : 1.0f;
            const int fbase = 16 * (wc & 1) + 4 * fq;
#pragma unroll
            for (int ai = 0; ai < 2; ++ai)
#pragma unroll
                for (int m = 0; m < 4; ++m) {
                    const int row = row0 + ai * 128 + m * 16, t = row & (SEQ - 1), pos = (wc < 2) ? (t >> 6) : (t & 63);
                    const af4 cs = *(const GAS af4*)(rope + pos * 32 + fbase), sn = *(const GAS af4*)(rope + 4096 + pos * 32 + fbase);
                    bf16* rowp = Z + (size_t)row * ZLD + col0;
#pragma unroll
                    for (int bj = 0; bj < 2; ++bj) {
                        const af4 x1 = acc[ai][bj][m][0], x2 = acc[ai][bj][m][1];
                        const af4 o1 = (x1 * cs - x2 * sn) * qs, o2 = (x2 * cs + x1 * sn) * qs;
                        v4u w; w.x = pk2(o1[0], o1[1]); w.y = pk2(o1[2], o1[3]); w.z = pk2(o2[0], o2[1]); w.w = pk2(o2[2], o2[3]);
                        *(GAS v4u*)(rowp + bj * 128) = w;
                    }
                }
        } else if (pn == 10 || pn == 11) {
#pragma unroll
            for (int ai = 0; ai < 2; ++ai)
#pragma unroll
                for (int m = 0; m < 4; ++m) {
                    const int row = row0 + ai * 128 + m * 16;
                    int b, tpos;
                    if (row < MLAT) { b = row >> 13; tpos = row & (SEQ - 1); } else { const int rr = row - MLAT; b = rr >> 8; tpos = SEQ + (rr & 255); }
                    const int k32 = tpos & 31, sp = (tpos & ~31) + ((k32 < 16) ? (8 * (k32 >> 2) + (k32 & 3)) : (8 * ((k32 - 16) >> 2) + 4 + (k32 & 3)));
#pragma unroll
                    for (int bj = 0; bj < 2; ++bj) {
                        const int hk = (pn - 10) * 2 + bj;
                        bf16* vp = VTA + ((size_t)(b * 4 + hk) * 128 + wc * 32 + 8 * fq) * VTLD + sp;
#pragma unroll
                        for (int n = 0; n < 2; ++n)
#pragma unroll
                            for (int e = 0; e < 4; ++e) vp[(size_t)(4 * n + e) * VTLD] = (bf16)f2bf(acc[ai][bj][m][n][e]);
                    }
                }
        } else {
            const bool th0 = (pn == 52), th1 = (pn == 52) && (wc < 2);
#pragma unroll
            for (int ai = 0; ai < 2; ++ai)
#pragma unroll
                for (int m = 0; m < 4; ++m) {
                    bf16* rowp = Z + (size_t)(row0 + ai * 128 + m * 16) * ZLD + col0;
#pragma unroll
                    for (int bj = 0; bj < 2; ++bj) {
                        af4 v0 = acc[ai][bj][m][0], v1 = acc[ai][bj][m][1];
                        if (bj == 0 ? th0 : th1) {
#pragma unroll
                            for (int e = 0; e < 4; ++e) { v0[e] = tanhf_(v0[e]); v1[e] = tanhf_(v1[e]); }
                        }
                        v4u w; w.x = pk2(v0[0], v0[1]); w.y = pk2(v0[2], v0[3]); w.z = pk2(v1[0], v1[1]); w.w = pk2(v1[2], v1[3]);
                        *(GAS v4u*)(rowp + bj * 128) = w;
                    }
                }
        }
    }
};
struct EpiLora {
    static constexpr bool PERM = true;
    const float *w0, *a0, *k_a; const bf16 *Kb, *KKb; bf16 *E, *KD, *KKA;
    __device__ __forceinline__ void operator()(const af4 (&acc)[2][2][4][2], const pg8::Unit& u, int wr, int wc, int fr, int fq) const {
        const int kind = u.pn >> 3, dir = kind & 1, cb = (u.pn & 7) * 256 + wc * 32 + 8 * fq, row0 = u.pm * 256 + wr * 64 + fr;
        if (kind < 2) {
#pragma unroll
            for (int bj = 0; bj < 2; ++bj) {
                const int c = cb + bj * 128;
                const af4 b0 = *(const GAS af4*)(w0 + dir * BW + c), b1 = *(const GAS af4*)(w0 + dir * BW + c + 4);
#pragma unroll
                for (int ai = 0; ai < 2; ++ai)
#pragma unroll
                    for (int m = 0; m < 4; ++m) {
                        const int row = row0 + ai * 128 + m * 16;
                        const af4 x0 = acc[ai][bj][m][0] + b0, x1 = acc[ai][bj][m][1] + b1;
                        float o[8];
#pragma unroll
                        for (int e = 0; e < 4; ++e) { o[e] = 0.6065306597126334f * sigmoidf_(x0[e]); o[4 + e] = 0.6065306597126334f * sigmoidf_(x1[e]); }
                        *(GAS v4u*)(E + ((size_t)dir * MALL + row) * BW + c) = pack8(o);
                    }
            }
        } else {
#pragma unroll
            for (int bj = 0; bj < 2; ++bj) {
                const int c = cb + bj * 128;
                const af4 b0 = *(const GAS af4*)(a0 + dir * BW + c), b1 = *(const GAS af4*)(a0 + dir * BW + c + 4);
                const af4 ka0 = *(const GAS af4*)(k_a + c), ka1 = *(const GAS af4*)(k_a + c + 4);
#pragma unroll
                for (int ai = 0; ai < 2; ++ai)
#pragma unroll
                    for (int m = 0; m < 4; ++m) {
                        const int row = row0 + ai * 128 + m * 16;
                        const af4 x0 = acc[ai][bj][m][0] + b0, x1 = acc[ai][bj][m][1] + b1;
                        float kf[8], kkf[8], okd[8], okka[8];
                        unpack8(*(const GAS v4u*)(Kb + (size_t)row * BW + c), kf); unpack8(*(const GAS v4u*)(KKb + (size_t)row * BW + c), kkf);
#pragma unroll
                        for (int e = 0; e < 4; ++e) {
                            const float s0 = sigmoidf_(x0[e]), s1 = sigmoidf_(x1[e]);
                            okd[e] = kf[e] * (1.0f + (s0 - 1.0f) * ka0[e]); okd[4 + e] = kf[4 + e] * (1.0f + (s1 - 1.0f) * ka1[e]);
                            okka[e] = kkf[e] * s0; okka[4 + e] = kkf[4 + e] * s1;
                        }
                        *(GAS v4u*)(KD + ((size_t)dir * MALL + row) * BW + c) = pack8(okd);
                        *(GAS v4u*)(KKA + ((size_t)dir * MALL + row) * BW + c) = pack8(okka);
                    }
            }
        }
    }
};
struct EpiResid {
    static constexpr bool PERM = false;
    const float* base; float* out; const float* gate;
    __device__ __forceinline__ void operator()(const af4 (&acc)[2][2][4][2], const pg8::Unit& u, int wr, int wc, int fr, int fq) const {
        const int row0 = u.pm * 256 + wr * 64 + fr, col0 = u.pn * 256 + wc * 32 + 4 * fq;
        const float* gp = gate + (size_t)(u.pm >> 5) * 3 * D;
        af4 gv[2][2];
#pragma unroll
        for (int bj = 0; bj < 2; ++bj)
#pragma unroll
            for (int n = 0; n < 2; ++n) gv[bj][n] = *(const GAS af4*)(gp + col0 + bj * 128 + n * 16);
#pragma unroll
        for (int ai = 0; ai < 2; ++ai)
#pragma unroll
            for (int m = 0; m < 4; ++m) {
                const size_t off = (size_t)(row0 + ai * 128 + m * 16) * D + col0;
#pragma unroll
                for (int bj = 0; bj < 2; ++bj)
#pragma unroll
                    for (int n = 0; n < 2; ++n) { const af4 bs = *(const GAS af4*)(base + off + bj * 128 + n * 16); *(GAS af4*)(out + off + bj * 128 + n * 16) = bs + gv[bj][n] * acc[ai][bj][m][n]; }
            }
    }
};
struct EpiVT {
    static constexpr bool PERM = true;
    bf16* VT; float* statp;
    __device__ __forceinline__ void operator()(const af4 (&acc)[2][2][4][2], const pg8::Unit& u, int wr, int wc, int fr, int fq) const {
        const int row0 = u.pm * 256 + wr * 64 + fr, col0 = u.pn * 256 + wc * 32 + 8 * fq;
#pragma unroll
        for (int ai = 0; ai < 2; ++ai)
#pragma unroll
            for (int m = 0; m < 4; ++m) {
                const int row = row0 + ai * 128 + m * 16;
                float s1 = 0.f, s2 = 0.f;
#pragma unroll
                for (int bj = 0; bj < 2; ++bj)
#pragma unroll
                    for (int n = 0; n < 2; ++n)
#pragma unroll
                        for (int e = 0; e < 4; ++e) {
                            const float gv = gelu_tanh(acc[ai][bj][m][n][e]);
                            s1 += gv; s2 += gv * gv;
                            VT[(size_t)(col0 + bj * 128 + 4 * n + e) * MLAT + row] = (bf16)f2bf(gv);
                        }
                s1 += __shfl_xor(s1, 16); s1 += __shfl_xor(s1, 32); s2 += __shfl_xor(s2, 16); s2 += __shfl_xor(s2, 32);
                if (fq == 0) *(GAS f32x2*)(statp + ((size_t)row * 192 + u.pn * 4 + wc) * 2) = (f32x2){s1, s2};
            }
    }
};
struct EpiGate {
    static constexpr bool PERM = true;
    const bf16* VT; const float* stats; const bf16* wsb; const float *bs, *lng, *lnb; bf16* Y;
    __device__ __forceinline__ void operator()(const af4 (&acc)[2][2][4][2], const pg8::Unit& u, int wr, int wc, int fr, int fq) const {
        const int lane = fr + 16 * fq;
        const int chbase = u.pn * 128, grp = u.pn / 6;
        const bf16* wsg = wsb + (size_t)grp * 128 * 128;
        const int chl = chbase + 32 * wc + 8 * (fr >> 2) + (fr & 3);
        float lg[2], lb[2];
#pragma unroll
        for (int n = 0; n < 2; ++n) { lg[n] = lng[chl + 4 * n]; lb[n] = lnb[chl + 4 * n]; }
#pragma unroll
        for (int ai = 0; ai < 2; ++ai) {
            const int tok0 = u.pm * 256 + ai * 128;
            bf16x8 av[2][4];
#pragma unroll
            for (int ks = 0; ks < 4; ++ks) {
                const int j0 = tok0 + 32 * ks + 8 * fq;
                f32x4 st[4];
#pragma unroll
                for (int q = 0; q < 4; ++q) st[q] = *(const GAS f32x4*)(stats + (size_t)(j0 + 2 * q) * 2);
#pragma unroll
                for (int n = 0; n < 2; ++n) {
                    float vf[8];
                    unpack8(*(const GAS v4u*)(VT + (size_t)(chl + 4 * n) * MLAT + j0), vf);
#pragma unroll
                    for (int q = 0; q < 4; ++q) { vf[2 * q] = (vf[2 * q] - st[q].x) * st[q].y * lg[n] + lb[n]; vf[2 * q + 1] = (vf[2 * q + 1] - st[q].z) * st[q].w * lg[n] + lb[n]; }
                    av[n][ks] = __builtin_bit_cast(bf16x8, pack8(vf));
                }
            }
#pragma unroll
            for (int m = 0; m < 4; ++m) {
                const int it = wr * 64 + m * 16 + fr;
                af4 vm[2] = {(af4){0.f, 0.f, 0.f, 0.f}, (af4){0.f, 0.f, 0.f, 0.f}};
#pragma unroll
                for (int ks = 0; ks < 4; ++ks) {
                    const bf16x8 wf = *(const GAS bf16x8*)(wsg + (size_t)it * 128 + 32 * ks + 8 * fq);
#pragma unroll
                    for (int n = 0; n < 2; ++n) vm[n] = __builtin_amdgcn_mfma_f32_16x16x32_bf16(av[n][ks], wf, vm[n], 0, 0, 0);
                }
                const float bsi = bs[grp * 128 + it];
                float o[8];
#pragma unroll
                for (int n = 0; n < 2; ++n)
#pragma unroll
                    for (int e = 0; e < 4; ++e) o[4 * n + e] = gelu_tanh(acc[ai][0][m][n][e]) * (vm[n][e] + bsi) * siluf_(acc[ai][1][m][n][e]);
                *(GAS v4u*)(Y + (size_t)(tok0 + it) * CW + chbase + 32 * wc + 8 * fq) = pack8(o);
            }
        }
        (void)lane;
    }
};

__device__ __forceinline__ void attn_unit(const Args& a, int unit, int lane, int wave) {
    const bf16* Z = (const bf16*)(a.ws + WS_Z); const bf16* VTA = (const bf16*)(a.ws + WS_VTA); bf16* OAB = (bf16*)(a.ws + WS_OAB);
    const int hp = unit & 1, hk = (unit >> 1) & 3, nblk = (unit >> 3) & 63, b = unit >> 9;
    const int hq = 4 * hk + 2 * hp + (wave >> 2), qoff = 32 * (wave & 3);
    const int c16 = lane & 15, g = lane >> 4;
    bf16x8 qf[2][4];
#pragma unroll
    for (int qt = 0; qt < 2; ++qt) {
        const size_t row = (size_t)b * SEQ + nblk * 128 + qoff + 16 * qt + c16;
#pragma unroll
        for (int ks = 0; ks < 4; ++ks) qf[qt][ks] = *(const GAS bf16x8*)(Z + row * ZLD + ZQ + hq * 128 + 32 * ks + 8 * g);
    }
    const float sinkl2 = a.in[I_SINK][hq] * 1.4426950408889634f;
    float mrun[2] = {sinkl2, sinkl2}, lpart[2] = {0.f, 0.f};
    af4 O[2][8];
#pragma unroll
    for (int qt = 0; qt < 2; ++qt)
#pragma unroll
        for (int dt = 0; dt < 8; ++dt) O[qt][dt] = (af4){0.f, 0.f, 0.f, 0.f};
    const bf16* vtb = VTA + (size_t)(b * 4 + hk) * 128 * VTLD;
    for (int st = 0; st < 10; ++st) {
        int krow0, tpos0, kk0; bool band = st >= 4;
        if (!band) { krow0 = MLAT + b * CTXL + 64 * st; tpos0 = SEQ + 64 * st; kk0 = 0; }
        else {
            const int bi = (st - 4) >> 1, hf = (st - 4) & 1, nb = nblk - 1 + bi;
            if (nb < 0 || nb > 63) continue;
            krow0 = b * SEQ + nb * 128 + 64 * hf; tpos0 = nb * 128 + 64 * hf; kk0 = bi * 128 + 64 * hf;
        }
        af4 S[2][4];
#pragma unroll
        for (int t4 = 0; t4 < 4; ++t4) {
            const bf16* kp = Z + (size_t)(krow0 + 16 * t4 + c16) * ZLD + ZK + hk * 128 + 8 * g;
            bf16x8 kf[4];
#pragma unroll
            for (int ks = 0; ks < 4; ++ks) kf[ks] = *(const GAS bf16x8*)(kp + 32 * ks);
#pragma unroll
            for (int qt = 0; qt < 2; ++qt) {
                af4 s = (af4){0.f, 0.f, 0.f, 0.f};
#pragma unroll
                for (int ks = 0; ks < 4; ++ks) s = __builtin_amdgcn_mfma_f32_16x16x32_bf16(kf[ks], qf[qt][ks], s, 0, 0, 0);
                S[qt][t4] = s;
            }
        }
        bf16x8 pf[2][2];
#pragma unroll
        for (int qt = 0; qt < 2; ++qt) {
            if (band) {
                const int qi = qoff + 16 * qt + c16;
#pragma unroll
                for (int t4 = 0; t4 < 4; ++t4)
#pragma unroll
                    for (int r = 0; r < 4; ++r) { const int kk = kk0 + 16 * t4 + 4 * g + r; if (kk < qi || kk > qi + 256) S[qt][t4][r] = -INFINITY; }
            }
            float mx = S[qt][0][0];
#pragma unroll
            for (int t4 = 0; t4 < 4; ++t4)
#pragma unroll
                for (int r = 0; r < 4; ++r) mx = fmaxf(mx, S[qt][t4][r]);
            mx = fmaxf(mx, __shfl_xor(mx, 16)); mx = fmaxf(mx, __shfl_xor(mx, 32));
            const float mnew = fmaxf(mrun[qt], mx), alpha = fexp2(mrun[qt] - mnew);
            mrun[qt] = mnew;
            float ps = 0.f;
#pragma unroll
            for (int t4 = 0; t4 < 4; ++t4)
#pragma unroll
                for (int r = 0; r < 4; ++r) { const float p = fexp2(S[qt][t4][r] - mnew); S[qt][t4][r] = p; ps += p; }
            lpart[qt] = lpart[qt] * alpha + ps;
#pragma unroll
            for (int dt = 0; dt < 8; ++dt) O[qt][dt] *= alpha;
#pragma unroll
            for (int k2 = 0; k2 < 2; ++k2) {
                v4u w; w.x = pk2(S[qt][2 * k2][0], S[qt][2 * k2][1]); w.y = pk2(S[qt][2 * k2][2], S[qt][2 * k2][3]);
                w.z = pk2(S[qt][2 * k2 + 1][0], S[qt][2 * k2 + 1][1]); w.w = pk2(S[qt][2 * k2 + 1][2], S[qt][2 * k2 + 1][3]);
                pf[qt][k2] = __builtin_bit_cast(bf16x8, w);
            }
        }
#pragma unroll
        for (int dt = 0; dt < 8; ++dt) {
            const bf16* vp = vtb + (size_t)(16 * dt + c16) * VTLD + tpos0 + 8 * g;
#pragma unroll
            for (int k2 = 0; k2 < 2; ++k2) {
                const bf16x8 vf = *(const GAS bf16x8*)(vp + 32 * k2);
#pragma unroll
                for (int qt = 0; qt < 2; ++qt) O[qt][dt] = __builtin_amdgcn_mfma_f32_16x16x32_bf16(vf, pf[qt][k2], O[qt][dt], 0, 0, 0);
            }
        }
    }
#pragma unroll
    for (int qt = 0; qt < 2; ++qt) {
        float L = lpart[qt]; L += __shfl_xor(L, 16); L += __shfl_xor(L, 32);
        L += fexp2(sinkl2 - mrun[qt]);
        const float inv = 1.0f / L;
        const size_t row = (size_t)b * SEQ + nblk * 128 + qoff + 16 * qt + c16;
#pragma unroll
        for (int dt = 0; dt < 8; ++dt) {
            const int d = 16 * dt + 4 * g;
            const v2u gw = *(const GAS v2u*)(Z + row * ZLD + ZGA + hq * 128 + d);
            const float g0 = bflo(gw.x), g1 = bfhi(gw.x), g2 = bflo(gw.y), g3 = bfhi(gw.y);
            v2u w; w.x = pk2(O[qt][dt][0] * inv * siluf_(g0), O[qt][dt][1] * inv * siluf_(g1)); w.y = pk2(O[qt][dt][2] * inv * siluf_(g2), O[qt][dt][3] * inv * siluf_(g3));
            *(GAS v2u*)(OAB + row * D + hq * 128 + d) = w;
        }
    }
}

__device__ __forceinline__ void rwkv_prep_item(const Args& a, int item, int lane) {
    const bf16* Z = (const bf16*)(a.ws + WS_Z);
    bf16* RK = (bf16*)(a.ws + WS_RKVK);
    const int row = item >> 2, c = (item & 3) * 512 + 8 * lane;
    bool hp, hn;
    if (row < MLAT) { const int t = row & (SEQ - 1); hp = t > 0; hn = t < SEQ - 1; } else { const int l = (row - MLAT) & (CTXL - 1); hp = l > 0; hn = l < CTXL - 1; }
    const float* cw = a.in[I_CONV];
    float outv[3][8];
#pragma unroll
    for (int qn = 0; qn < 3; ++qn) {
        const int zc = (qn == 0 ? ZR : (qn == 1 ? ZKB : ZVB)) + c;
        float x0[8], x1[8], x2[8];
        const v4u z4 = {0u, 0u, 0u, 0u};
        unpack8(hp ? *(const GAS v4u*)(Z + (size_t)(row - 1) * ZLD + zc) : z4, x0);
        unpack8(*(const GAS v4u*)(Z + (size_t)row * ZLD + zc), x1);
        unpack8(hn ? *(const GAS v4u*)(Z + (size_t)(row + 1) * ZLD + zc) : z4, x2);
        const float* w = cw + qn * BW + c;
#pragma unroll
        for (int h = 0; h < 2; ++h) {
            const af4 w0 = *(const GAS af4*)(w + 4 * h), w1 = *(const GAS af4*)(w + 3 * BW + 4 * h), w2 = *(const GAS af4*)(w + 6 * BW + 4 * h);
#pragma unroll
            for (int e = 0; e < 4; ++e) outv[qn][4 * h + e] = x0[4 * h + e] * w0[e] + x1[4 * h + e] * w1[e] + x2[4 * h + e] * w2[e];
        }
    }
    float kk[8]; float ss = 0.f;
    { const af4 k0 = *(const GAS af4*)(a.in[I_KK] + c), k1 = *(const GAS af4*)(a.in[I_KK] + c + 4);
#pragma unroll
      for (int e = 0; e < 4; ++e) { kk[e] = outv[1][e] * k0[e]; kk[4 + e] = outv[1][4 + e] * k1[e]; }
#pragma unroll
      for (int e = 0; e < 8; ++e) ss += kk[e] * kk[e]; }
    ss = sum8(ss);
    const float inv = 1.0f / fmaxf(sqrtf(ss), 1e-12f);
#pragma unroll
    for (int e = 0; e < 8; ++e) kk[e] *= inv;
    const size_t o = (size_t)row * BW + c, QS = (size_t)MALL * BW;
    *(GAS v4u*)(RK + o) = pack8(outv[0]); *(GAS v4u*)(RK + QS + o) = pack8(outv[1]); *(GAS v4u*)(RK + 2 * QS + o) = pack8(outv[2]); *(GAS v4u*)(RK + 3 * QS + o) = pack8(kk);
}

__device__ __forceinline__ void scan_block(const Args& a, LAS unsigned char* lds, int sid, int tid) {
    const int dir = sid & 1, h = (sid >> 1) & 31, b = sid >> 6;
    const bf16* RK = (const bf16*)(a.ws + WS_RKVK); const bf16* EK = (const bf16*)(a.ws + WS_EKK);
    const size_t QS = (size_t)MALL * BW;
    const bf16* qb[6] = { RK + 3 * QS, EK + (size_t)dir * QS, EK + (size_t)(4 + dir) * QS, EK + (size_t)(2 + dir) * QS, RK, RK + 2 * QS };
    bf16* YS = (bf16*)(a.ws + WS_YS) + (size_t)dir * MLAT * BW;
    LAS float* buf = (LAS float*)lds;
    LAS float* ybuf = (LAS float*)(lds + 98304);
    const int v = tid >> 3, e8 = tid & 7;
    constexpr int NCH = (CTXL + SEQ) / 32;
    auto rowof = [&](int s) -> int { return s < CTXL ? (MLAT + b * CTXL + (dir ? (CTXL - 1 - s) : s)) : (b * SEQ + (dir ? (SEQ - 1 - (s - CTXL)) : (s - CTXL))); };
    v4u pre[3];
    auto issue = [&](int ci) {
#pragma unroll
        for (int j = 0; j < 3; ++j) { const int pid = tid + 512 * j, sl = pid / 48, rem = pid % 48, qn = rem >> 3, part = rem & 7;
            const bf16* src = qn == 0 ? qb[0] : qn == 1 ? qb[1] : qn == 2 ? qb[2] : qn == 3 ? qb[3] : qn == 4 ? qb[4] : qb[5];
            pre[j] = *(const GAS v4u*)(src + (size_t)rowof(32 * ci + sl) * BW + h * 64 + 8 * part); }
    };
    auto commit = [&](int ci) {
        LAS float* bb = buf + (ci & 1) * (32 * 6 * 64);
#pragma unroll
        for (int j = 0; j < 3; ++j) { const int pid = tid + 512 * j, sl = pid / 48, rem = pid % 48, qn = rem >> 3, part = rem & 7;
            float f[8]; unpack8(pre[j], f);
            if (qn == 1) {
#pragma unroll
                for (int e = 0; e < 8; ++e) f[e] = fexp(-f[e]);
            }
            LAS float* dst = bb + (sl * 6 + qn) * 64 + 8 * part;
            *(LAS f32x4*)dst = (f32x4){f[0], f[1], f[2], f[3]}; *(LAS f32x4*)(dst + 4) = (f32x4){f[4], f[5], f[6], f[7]}; }
    };
    float S[8];
#pragma unroll
    for (int e = 0; e < 8; ++e) S[e] = 0.f;
    issue(0); commit(0);
    __syncthreads();
    for (int ci = 0; ci < NCH; ++ci) {
        if (ci + 1 < NCH) issue(ci + 1);
        const LAS float* bb = buf + (ci & 1) * (32 * 6 * 64);
        LAS float* yb = ybuf + (ci & 1) * (32 * 64);
#pragma unroll 2
        for (int sl = 0; sl < 32; ++sl) {
            const LAS float* p = bb + sl * 6 * 64 + 8 * e8;
            const f32x4 kk0 = *(const LAS f32x4*)(p), kk1 = *(const LAS f32x4*)(p + 4);
            const f32x4 w0 = *(const LAS f32x4*)(p + 64), w1 = *(const LAS f32x4*)(p + 68);
            const f32x4 ka0 = *(const LAS f32x4*)(p + 128), ka1 = *(const LAS f32x4*)(p + 132);
            const f32x4 kd0 = *(const LAS f32x4*)(p + 192), kd1 = *(const LAS f32x4*)(p + 196);
            const f32x4 r0 = *(const LAS f32x4*)(p + 256), r1 = *(const LAS f32x4*)(p + 260);
            const float vv = bb[sl * 6 * 64 + 320 + v];
            float sk = (S[0] * kk0.x + S[1] * kk0.y) + (S[2] * kk0.z + S[3] * kk0.w) + (S[4] * kk1.x + S[5] * kk1.y) + (S[6] * kk1.z + S[7] * kk1.w);
            sk = sum8(sk);
            const float nsk = -sk;
            S[0] = S[0] * w0.x + (nsk * ka0.x + vv * kd0.x); S[1] = S[1] * w0.y + (nsk * ka0.y + vv * kd0.y);
            S[2] = S[2] * w0.z + (nsk * ka0.z + vv * kd0.z); S[3] = S[3] * w0.w + (nsk * ka0.w + vv * kd0.w);
            S[4] = S[4] * w1.x + (nsk * ka1.x + vv * kd1.x); S[5] = S[5] * w1.y + (nsk * ka1.y + vv * kd1.y);
            S[6] = S[6] * w1.z + (nsk * ka1.z + vv * kd1.z); S[7] = S[7] * w1.w + (nsk * ka1.w + vv * kd1.w);
            float y = (S[0] * r0.x + S[1] * r0.y) + (S[2] * r0.z + S[3] * r0.w) + (S[4] * r1.x + S[5] * r1.y) + (S[6] * r1.z + S[7] * r1.w);
            y = sum8(y);
            if (e8 == 0) yb[sl * 64 + v] = y;
        }
        if (ci + 1 < NCH) commit(ci + 1);
        __syncthreads();
        if (ci >= CTXL / 32 && tid < 256) {
            const int sl = tid >> 3, part = tid & 7;
            const LAS float* ys = yb + sl * 64 + 8 * part;
            const f32x4 y0 = *(const LAS f32x4*)ys, y1 = *(const LAS f32x4*)(ys + 4);
            v4u w; w.x = pk2(y0.x, y0.y); w.y = pk2(y0.z, y0.w); w.z = pk2(y1.x, y1.y); w.w = pk2(y1.z, y1.w);
            *(GAS v4u*)(YS + (size_t)rowof(32 * ci + sl) * BW + h * 64 + 8 * part) = w;
        }
    }
    __syncthreads();
}

__device__ __forceinline__ void readout_item(const Args& a, int item, int lane) {
    const bf16* Z = (const bf16*)(a.ws + WS_Z); const bf16* RK = (const bf16*)(a.ws + WS_RKVK); const bf16* YS = (const bf16*)(a.ws + WS_YS); bf16* OAB = (bf16*)(a.ws + WS_OAB);
    const int row = item >> 2, c = (item & 3) * 512 + 8 * lane;
    const size_t o = (size_t)row * BW + c, QS = (size_t)MALL * BW;
    float y0[8], y1[8], r[8], k[8], vv[8], gb[8];
    unpack8(*(const GAS v4u*)(YS + o), y0); unpack8(*(const GAS v4u*)(YS + (size_t)MLAT * BW + o), y1);
    unpack8(*(const GAS v4u*)(RK + o), r); unpack8(*(const GAS v4u*)(RK + QS + o), k); unpack8(*(const GAS v4u*)(RK + 2 * QS + o), vv);
    unpack8(*(const GAS v4u*)(Z + (size_t)row * ZLD + ZGB + c), gb);
    float rk[8], gw[8], gbias[8];
#pragma unroll
    for (int h = 0; h < 2; ++h) { const af4 t0 = *(const GAS af4*)(a.in[I_RK] + c + 4 * h), t1 = *(const GAS af4*)(a.in[I_GNW] + c + 4 * h), t2 = *(const GAS af4*)(a.in[I_GNB] + c + 4 * h);
#pragma unroll
        for (int e = 0; e < 4; ++e) { rk[4 * h + e] = t0[e]; gw[4 * h + e] = t1[e]; gbias[4 * h + e] = t2[e]; } }
    float s = 0.f, bon = 0.f;
#pragma unroll
    for (int e = 0; e < 8; ++e) { y0[e] += y1[e]; s += y0[e]; bon += r[e] * k[e] * rk[e]; }
    s = sum8(s); bon = sum8(bon);
    const float mean = s * (1.0f / 64.0f); float q = 0.f;
#pragma unroll
    for (int e = 0; e < 8; ++e) { y0[e] -= mean; q += y0[e] * y0[e]; }
    q = sum8(q);
    const float rstd = 1.0f / sqrtf(q * (1.0f / 64.0f) + 64e-5f);
    float outv[8];
#pragma unroll
    for (int e = 0; e < 8; ++e) outv[e] = (y0[e] * rstd * gw[e] + gbias[e] + bon * vv[e]) * siluf_(gb[e]);
    *(GAS v4u*)(OAB + (size_t)row * D + BW + c) = pack8(outv);
}

__global__ void __launch_bounds__(NTHREADS, 2) fwd(Args a) {
    extern __shared__ __attribute__((aligned(16))) unsigned char lds_raw[];
    LAS unsigned char* lds = (LAS unsigned char*)lds_raw;
    const int G = gridDim.x, bx = blockIdx.x;
    unsigned char* ws = a.ws;
    volatile LAS unsigned* MISC = (volatile LAS unsigned*)(lds + LDSCTL_OFF);
    if (threadIdx.x < 64) MISC[threadIdx.x] = 0u;
    __syncthreads();
    XcdBarrier bar; bar.bar = (unsigned*)(ws + WS_CTL) + CW_BAR; bar.x = 0; bar.st = nullptr;
    if (MK_N_LAUNCHES == 1) bar = xcd_barrier_post((unsigned*)(ws + WS_CTL) + CW_BAR, MISC + 8);
    const int lo = a.ph_lo, hi = a.ph_hi;
#define IN(k) (lo <= (k) && (k) < hi)
#define SEAM(k) do { if (IN(k) && IN((k) + 1)) xcd_barrier(bar); } while (0)
    const int NGW = G * NWAVES;
    float* modv = (float*)(ws + WS_MODV);

    if (IN(0)) { p0_phase(a, lds); }
    SEAM(0);
    if (IN(1)) { norm_phase(a, lds, 0, a.in[I_X], a.in[I_CTX], MALL); }
    SEAM(1);
    if (IN(2)) {
        pg8::Gemm g{(const bf16*)(ws + WS_H), (const bf16*)(ws + WS_WIN0), MALL, ZLD, D, D}; pg8::StaticOrder S; S.init(MALL, ZLD, G, bx);
        EpiZ E{(bf16*)(ws + WS_Z), (bf16*)(ws + WS_VTA), (const float*)(ws + WS_ROPE)};
        pg8::gemm_phase<EpiZ, pg8::StaticOrder, true, true>(lds, g, S, E);
    }
    SEAM(2);
    if (IN(3)) {
        const int tid = my_tid(), lane = tid & 63, wave = __builtin_amdgcn_readfirstlane(tid >> 6), gw = bx * NWAVES + wave;
        for (int u = bx; u < 1024; u += G) attn_unit(a, u, lane, wave);
        for (int it = gw; it < MALL * 4; it += NGW) rwkv_prep_item(a, it, lane);
    }
    SEAM(3);
    if (IN(4)) {
        pg8::Gemm g{(const bf16*)(ws + WS_Z) + ZDL, (const bf16*)(ws + WS_WLORA), MALL, 8192, 384, ZLD}; pg8::StaticOrder S; S.init(MALL, 8192, G, bx);
        const bf16* RK = (const bf16*)(ws + WS_RKVK); bf16* EK = (bf16*)(ws + WS_EKK); const size_t QS = (size_t)MALL * BW;
        EpiLora E{a.in[I_W0], a.in[I_A0], a.in[I_KA], RK + QS, RK + 3 * QS, EK, EK + 2 * QS, EK + 4 * QS};
        pg8::gemm_phase<EpiLora, pg8::StaticOrder, true, true>(lds, g, S, E);
    }
    SEAM(4);
    if (IN(5)) { const int tid = my_tid(); for (int sid = bx; sid < 128; sid += G) scan_block(a, lds, sid, tid); }
    SEAM(5);
    if (IN(6)) { const int tid = my_tid(), lane = tid & 63, gw = bx * NWAVES + __builtin_amdgcn_readfirstlane(tid >> 6); for (int it = gw; it < MLAT * 4; it += NGW) readout_item(a, it, lane); }
    SEAM(6);
    if (IN(7)) {
        pg8::Gemm g{(const bf16*)(ws + WS_OAB), (const bf16*)(ws + WS_WOUT0), MLAT, D, D, D}; pg8::StaticOrder S; S.init(MLAT, D, G, bx);
        EpiResid E{a.in[I_X], (float*)(ws + WS_X1), modv + 2 * D};
        pg8::gemm_phase<EpiResid, pg8::StaticOrder, true, true>(lds, g, S, E);
    }
    SEAM(7);
    if (IN(8)) { norm_phase(a, lds, 1, (const float*)(ws + WS_X1), nullptr, MLAT); }
    SEAM(8);
    if (IN(9)) {
        pg8::Gemm g{(const bf16*)(ws + WS_H), (const bf16*)(ws + WS_WGIN), MLAT, CW, D, D}; pg8::StaticOrder S; S.init(MLAT, CW, G, bx);
        EpiVT E{(bf16*)(ws + WS_VT), (float*)(ws + WS_STATP)};
        pg8::gemm_phase<EpiVT, pg8::StaticOrder, true, true>(lds, g, S, E);
    }
    SEAM(9);
    if (IN(10)) {
        const int tid = my_tid(), lane = tid & 63, gw = bx * NWAVES + __builtin_amdgcn_readfirstlane(tid >> 6);
        const float* sp = (const float*)(ws + WS_STATP); float* st = (float*)(ws + WS_STATS);
        for (int row = gw; row < MLAT; row += NGW) {
            float s1 = 0.f, s2 = 0.f;
#pragma unroll
            for (int j = 0; j < 3; ++j) { const f32x2 p = *(const GAS f32x2*)(sp + ((size_t)row * 192 + lane + 64 * j) * 2); s1 += p.x; s2 += p.y; }
            s1 = wave_sum(s1); s2 = wave_sum(s2);
            const float mean = s1 * (1.0f / CW), var = fmaxf(s2 * (1.0f / CW) - mean * mean, 0.f);
            if (lane == 0) *(GAS f32x2*)(st + (size_t)row * 2) = (f32x2){mean, 1.0f / sqrtf(var + 1e-5f)};
        }
    }
    SEAM(10);
    if (IN(11)) {
        pg8::Gemm g{(const bf16*)(ws + WS_H), (const bf16*)(ws + WS_WGIN) + (size_t)CW * D, MLAT, 2 * CW, D, D}; pg8::StaticOrder S; S.init(MLAT, 2 * CW, G, bx);
        EpiGate E{(const bf16*)(ws + WS_VT), (const float*)(ws + WS_STATS), (const bf16*)(ws + WS_WSB), a.in[I_BS], a.in[I_LNG], a.in[I_LNB], (bf16*)(ws + WS_Y)};
        pg8::gemm_phase<EpiGate, pg8::StaticOrder, true, true>(lds, g, S, E);
    }
    SEAM(11);
    if (IN(12)) {
        pg8::Gemm g{(const bf16*)(ws + WS_Y), (const bf16*)(ws + WS_WGOUT), MLAT, D, CW, CW}; pg8::StaticOrder S; S.init(MLAT, D, G, bx);
        EpiResid E{(const float*)(ws + WS_X1), a.out, modv + 3 * 3 * D + 2 * D};
        pg8::gemm_phase<EpiResid, pg8::StaticOrder, true, true>(lds, g, S, E);
    }
    SEAM(12);
    if (IN(13)) {
        const int tid = my_tid(), lane = tid & 63, gw = bx * NWAVES + __builtin_amdgcn_readfirstlane(tid >> 6);
        const float* fg = a.in[I_FING];
        for (int row = gw; row < MLAT; row += NGW) {
            GAS f32x4* xp = (GAS f32x4*)(a.out + (size_t)row * D) + lane;
            f32x4 v[16]; float s = 0.f;
#pragma unroll
            for (int q = 0; q < 16; ++q) { v[q] = xp[64 * q]; s += (v[q].x * v[q].x + v[q].y * v[q].y) + (v[q].z * v[q].z + v[q].w * v[q].w); }
            const float rstd = 1.0f / sqrtf(wave_sum(s) * (1.0f / D) + 1e-6f);
#pragma unroll
            for (int q = 0; q < 16; ++q) { const f32x4 gg = *(const GAS f32x4*)(fg + 4 * lane + 256 * q); xp[64 * q] = v[q] * rstd * gg; }
        }
    }
#undef IN
#undef SEAM
}

extern "C" void kernel_launch(void* const* d_in, const int* in_sizes, int n_in, void* d_out, int out_size, void* d_ws, size_t ws_size, hipStream_t stream) {
    static int grid = 0;
    if (grid == 0) {
        if (n_in != 27 || in_sizes[0] != MLAT * D || out_size != MLAT * D || ws_size < WS_END) { fprintf(stderr, "kernel_launch: unexpected shapes (n_in %d, ws %zu < %zu?)\n", n_in, ws_size, (size_t)WS_END); grid = -1; return; }
        int dev = 0, cus = 0, per_cu = 0;
        if (hipGetDevice(&dev) != hipSuccess || hipDeviceGetAttribute(&cus, hipDeviceAttributeMultiprocessorCount, dev) != hipSuccess) { grid = -1; return; }
        if (hipFuncSetAttribute((const void*)fwd, hipFuncAttributeMaxDynamicSharedMemorySize, LDS_BYTES) != hipSuccess) { fprintf(stderr, "kernel_launch: hipFuncSetAttribute failed\n"); grid = -1; return; }
        if (hipOccupancyMaxActiveBlocksPerMultiprocessor(&per_cu, (const void*)fwd, NTHREADS, LDS_BYTES) != hipSuccess || per_cu < 1) { fprintf(stderr, "kernel_launch: occupancy query says %d\n", per_cu); }
        (void)hipGetLastError();
        grid = cus;
    }
    if (grid < 0) return;
    if (hipMemsetAsync((char*)d_ws + WS_CTL, 0, CTL_ZERO_BYTES, stream) != hipSuccess) return;
    Args a{};
    for (int i = 0; i < 27; ++i) a.in[i] = (const float*)d_in[i];
    a.out = (float*)d_out; a.ws = (unsigned char*)d_ws;
    if (MK_N_LAUNCHES == 1) { a.ph_lo = 0; a.ph_hi = NPHASE; hipLaunchKernelGGL(fwd, dim3(grid), dim3(NTHREADS), LDS_BYTES, stream, a); }
    else for (int p = 0; p < NPHASE; ++p) { a.ph_lo = p; a.ph_hi = p + 1; hipLaunchKernelGGL(fwd, dim3(grid), dim3(NTHREADS), LDS_BYTES, stream, a); }
}
```

```cpp
#include <hip/hip_runtime.h>
#include <cstdio>
#include <cstdint>

#define REP_PHASE -1
#define REP_COUNT 2
#ifndef MK_N_LAUNCHES
#define MK_N_LAUNCHES 1
#endif

namespace pg8 {
#define PG8_LAS __attribute__((address_space(3)))
typedef unsigned short bf16_t;
typedef short bf16x8 __attribute__((ext_vector_type(8)));
typedef float f32x4 __attribute__((ext_vector_type(4)));
typedef unsigned u32x4 __attribute__((ext_vector_type(4)));
constexpr int BM = 256, BK = 64, HALF = 128, HTB = HALF * BK * 2, STAGE_BYTES = 8 * HTB, NXCD = 8, WGM = 8;

__host__ __device__ __forceinline__ int lds_byte(int r, int c) { const int st = (r >> 4) * 2 + (c >> 5), rr = r & 15, cc = c & 31, ob = rr * 64 + cc * 2; return st * 1024 + (ob ^ (((ob >> 9) & 1) << 5)); }
__host__ __device__ __forceinline__ void stage_rc(int b, int& R, int& C) { const int st = b / 1024, sb = b % 1024, swz = sb ^ (((sb >> 9) & 1) << 5); R = (st >> 1) * 16 + swz / 64; C = (st & 1) * 32 + (swz % 64) / 2; }
__host__ __device__ __forceinline__ int perm32(int rho) { const int n = rho >> 4, i = rho & 15; return 8 * (i >> 2) + 4 * n + (i & 3); }

struct Unit { int pm, pn; };
struct Gemm { const bf16_t* A; const bf16_t* Bt; int M, N, K, lda; int a_shift = 0, a_stride = 0; };

struct StaticOrder {
    int nM, nN, nwg, G, c;
    __host__ __device__ void init(int M, int N, int G_, int c_) { nM = M / BM; nN = N / BM; nwg = nM * nN; G = G_; c = c_; }
    __host__ __device__ bool next(int i, Unit& u) const {
        const long L = (long)i * G + c; if (L >= nwg) return false;
        int wgid = (int)L; { const int q = nwg / NXCD, r = nwg % NXCD, xcd = wgid % NXCD, off = wgid / NXCD; wgid = (xcd < r ? xcd * (q + 1) : r * (q + 1) + (xcd - r) * q) + off; }
        const int nig = WGM * nN, gid = wgid / nig, fm = gid * WGM, gsz = (nM - fm) < WGM ? (nM - fm) : WGM;
        u.pm = fm + ((wgid % nig) % gsz); u.pn = (wgid % nig) / gsz; return true;
    }
    __device__ __forceinline__ void a_ready(const Unit&) const {}
    __device__ __forceinline__ void done(const Unit&) const {}
};

__device__ __forceinline__ unsigned cvt_pk_bf16(float lo, float hi) { unsigned r; asm volatile("v_cvt_pk_bf16_f32 %0, %1, %2" : "=v"(r) : "v"(lo), "v"(hi)); return r; }

template <class Epi, class Sched, bool ALIGN_EPI = false, bool SP2 = false>
__device__ __forceinline__ void gemm_phase(PG8_LAS unsigned char* lds, const Gemm g, const Sched& S, const Epi& E) {
    int tid = threadIdx.x; asm volatile("" : "+v"(tid)); const int wid = __builtin_amdgcn_readfirstlane(tid >> 6), lane = tid & 63, wr = wid >> 2, wc = wid & 3, fr = lane & 15, fq = lane >> 4;
    const int K = g.K, nt = K / BK, lda = g.lda;
    unsigned voffA[2], voffB[2];
#pragma unroll
    for (int i = 0; i < 2; ++i) { int R, C; stage_rc(tid * 16 + i * 8192, R, C); const int Rb = Epi::PERM ? ((R & ~31) + perm32(R & 31)) : R;
        voffA[i] = (unsigned)(R * lda + C) * 2u; voffB[i] = (unsigned)(Rb * K + C) * 2u; }
    const size_t kstep = (size_t)(BK * 2);
    const size_t hstepA = (size_t)HALF * lda * 2, hstepB = (size_t)HALF * K * 2;
    const size_t tstepA = 2 * hstepA, tstepB = 2 * hstepB;
    const unsigned ldsw = (unsigned)wid * 1024u;
    const int aoff = lds_byte(wr * 64 + fr, fq * 8), boff = lds_byte(wc * 32 + fr, fq * 8);
#define PG8_SA(b, h) (((b) * 2 + (h)) * HTB)
#define PG8_SB(b, h) ((4 + (b) * 2 + (h)) * HTB)
#define PG8_STAGE(bufoff, gbase, voff) do { _Pragma("unroll") for (int _i = 0; _i < 2; ++_i) \
        __builtin_amdgcn_global_load_lds((const unsigned*)((const char*)(gbase) + (voff)[_i]), (PG8_LAS unsigned*)(lds + (bufoff) + ldsw + _i * 8192), 16, 0, 0); } while (0)
#define PG8_LDA(dst, b, h) do { _Pragma("unroll") for (int m = 0; m < 4; ++m) _Pragma("unroll") for (int k = 0; k < 2; ++k) dst[m][k] = *(const PG8_LAS bf16x8*)(lds + PG8_SA(b, h) + aoff + m * 2048 + k * 1024); } while (0)
#define PG8_LDB(dst, b, h) do { _Pragma("unroll") for (int n = 0; n < 2; ++n) _Pragma("unroll") for (int k = 0; k < 2; ++k) dst[n][k] = *(const PG8_LAS bf16x8*)(lds + PG8_SB(b, h) + boff + n * 2048 + k * 1024); } while (0)
#define PG8_MMA(ai, bj, At, Bt) do { __builtin_amdgcn_s_setprio(1); _Pragma("unroll") for (int m = 0; m < 4; ++m) _Pragma("unroll") for (int n = 0; n < 2; ++n) _Pragma("unroll") for (int k = 0; k < 2; ++k) \
        acc[ai][bj][m][n] = __builtin_amdgcn_mfma_f32_16x16x32_bf16(Bt[n][k], At[m][k], acc[ai][bj][m][n], 0, 0, 0); __builtin_amdgcn_s_setprio(0); } while (0)
#define PG8_WAIT_V(n) asm volatile("s_waitcnt vmcnt(" #n ")" ::: "memory")
#define PG8_WAIT_L(n) asm volatile("s_waitcnt lgkmcnt(" #n ")" ::: "memory")
#define PG8_BAR __builtin_amdgcn_s_barrier()
#define PG8_SCHED __builtin_amdgcn_sched_barrier(0)
    Unit cur, nxt; int ui = 0;
    if (!S.next(0, cur)) return;
    f32x4 acc[2][2][4][2];
#pragma unroll
    for (int a = 0; a < 2; ++a)
#pragma unroll
        for (int b = 0; b < 2; ++b)
#pragma unroll
            for (int m = 0; m < 4; ++m)
#pragma unroll
                for (int n = 0; n < 2; ++n) acc[a][b][m][n] = (f32x4){0.f, 0.f, 0.f, 0.f};
    bf16x8 At[4][2], B0[2][2], B1[2][2];
    const char* cA = (const char*)g.A + (size_t)cur.pm * tstepA + (size_t)((cur.pn >> g.a_shift) * g.a_stride); const char* cB = (const char*)g.Bt + (size_t)cur.pn * tstepB;
    S.a_ready(cur);
    if constexpr (SP2) {
        PG8_STAGE(PG8_SB(0, 0), cB, voffB); PG8_STAGE(PG8_SB(0, 1), cB + hstepB, voffB); PG8_STAGE(PG8_SA(0, 0), cA, voffA); PG8_STAGE(PG8_SA(0, 1), cA + hstepA, voffA);
        if (wr == 1) PG8_BAR;
        PG8_WAIT_V(2); PG8_BAR;
        PG8_STAGE(PG8_SB(1, 0), cB + kstep, voffB); PG8_STAGE(PG8_SA(1, 0), cA + kstep, voffA); PG8_STAGE(PG8_SB(1, 1), cB + hstepB + kstep, voffB);
        PG8_WAIT_V(6); PG8_BAR;
    } else {
        PG8_STAGE(PG8_SB(0, 0), cB, voffB); PG8_STAGE(PG8_SA(0, 0), cA, voffA); PG8_STAGE(PG8_SB(0, 1), cB + hstepB, voffB); PG8_STAGE(PG8_SA(0, 1), cA + hstepA, voffA);
        if (wr == 1) PG8_BAR;
        PG8_WAIT_V(4); PG8_BAR;
        PG8_STAGE(PG8_SB(1, 0), cB + kstep, voffB); PG8_STAGE(PG8_SA(1, 0), cA + kstep, voffA); PG8_STAGE(PG8_SB(1, 1), cB + hstepB + kstep, voffB);
        PG8_WAIT_V(6); PG8_BAR;
    }
    for (;;) {
        const bool has_next = S.next(ui + 1, nxt);
        const char* nA = has_next ? (const char*)g.A + (size_t)nxt.pm * tstepA + (size_t)((nxt.pn >> g.a_shift) * g.a_stride) : cA; const char* nB = has_next ? (const char*)g.Bt + (size_t)nxt.pn * tstepB : cB;
#pragma clang loop unroll(disable)
        for (int t = 0; t < nt; t += 2) {
            const bool last = (t == nt - 2);
            const char* a1 = cA + (size_t)(t + 1) * kstep;
            const char* a2 = last ? nA : cA + (size_t)(t + 2) * kstep; const char* b2 = last ? nB : cB + (size_t)(t + 2) * kstep;
            const char* a3 = a2 + kstep; const char* b3 = b2 + kstep;
            if (last && has_next) S.a_ready(nxt);
            if constexpr (SP2) {
            PG8_LDB(B0, 0, 0); PG8_LDB(B1, 0, 1); PG8_SCHED; PG8_LDA(At, 0, 0); PG8_STAGE(PG8_SA(1, 1), a1 + hstepA, voffA);
            PG8_WAIT_V(8); PG8_WAIT_L(0); PG8_BAR; PG8_MMA(0, 0, At, B0); PG8_MMA(0, 1, At, B1); PG8_BAR; PG8_SCHED;
            PG8_LDA(At, 0, 1); PG8_STAGE(PG8_SB(0, 0), b2, voffB); PG8_STAGE(PG8_SB(0, 1), b2 + hstepB, voffB); PG8_STAGE(PG8_SA(0, 0), a2, voffA);
            PG8_WAIT_V(8); PG8_WAIT_L(0); PG8_BAR; PG8_MMA(1, 0, At, B0); PG8_MMA(1, 1, At, B1); PG8_BAR; PG8_SCHED;
            PG8_LDB(B0, 1, 0); PG8_LDB(B1, 1, 1); PG8_SCHED; PG8_LDA(At, 1, 0); PG8_STAGE(PG8_SA(0, 1), a2 + hstepA, voffA);
            PG8_WAIT_V(8); PG8_WAIT_L(0); PG8_BAR; PG8_MMA(0, 0, At, B0); PG8_MMA(0, 1, At, B1); PG8_BAR; PG8_SCHED;
            PG8_LDA(At, 1, 1); PG8_STAGE(PG8_SB(1, 0), b3, voffB); PG8_STAGE(PG8_SB(1, 1), b3 + hstepB, voffB); PG8_STAGE(PG8_SA(1, 0), a3, voffA);
            PG8_WAIT_V(8); PG8_WAIT_L(0); PG8_BAR; PG8_MMA(1, 0, At, B0); PG8_MMA(1, 1, At, B1); PG8_BAR; PG8_SCHED;
            } else {
            PG8_LDB(B0, 0, 0); PG8_SCHED; PG8_LDA(At, 0, 0); PG8_STAGE(PG8_SA(1, 1), a1 + hstepA, voffA);
            PG8_WAIT_L(8); PG8_BAR; PG8_WAIT_L(0); PG8_MMA(0, 0, At, B0); PG8_BAR; PG8_SCHED;
            PG8_LDB(B1, 0, 1); PG8_STAGE(PG8_SB(0, 0), b2, voffB);
            PG8_BAR; PG8_WAIT_L(0); PG8_MMA(0, 1, At, B1); PG8_BAR;
            PG8_LDA(At, 0, 1); PG8_STAGE(PG8_SA(0, 0), a2, voffA);
            PG8_BAR; PG8_WAIT_L(0); PG8_MMA(1, 0, At, B0); PG8_BAR; PG8_SCHED;
            PG8_STAGE(PG8_SB(0, 1), b2 + hstepB, voffB);
            PG8_WAIT_V(6); PG8_BAR; PG8_MMA(1, 1, At, B1); PG8_BAR;
            PG8_LDB(B0, 1, 0); PG8_SCHED; PG8_LDA(At, 1, 0); PG8_STAGE(PG8_SA(0, 1), a2 + hstepA, voffA);
            PG8_WAIT_L(8); PG8_BAR; PG8_WAIT_L(0); PG8_MMA(0, 0, At, B0); PG8_BAR; PG8_SCHED;
            PG8_LDB(B1, 1, 1); PG8_STAGE(PG8_SB(1, 0), b3, voffB);
            PG8_BAR; PG8_WAIT_L(0); PG8_MMA(0, 1, At, B1); PG8_BAR;
            PG8_LDA(At, 1, 1); PG8_STAGE(PG8_SA(1, 0), a3, voffA);
            PG8_BAR; PG8_WAIT_L(0); PG8_MMA(1, 0, At, B0); PG8_BAR; PG8_SCHED;
            PG8_STAGE(PG8_SB(1, 1), b3 + hstepB, voffB);
            PG8_WAIT_V(6); PG8_BAR; PG8_MMA(1, 1, At, B1); PG8_BAR;
            }
        }
        if constexpr (ALIGN_EPI) { if (wr == 0) PG8_BAR; }
        E(acc, cur, wr, wc, fr, fq);
        if (!has_next) break;
#pragma unroll
        for (int a = 0; a < 2; ++a)
#pragma unroll
            for (int b = 0; b < 2; ++b)
#pragma unroll
                for (int m = 0; m < 4; ++m)
#pragma unroll
                    for (int n = 0; n < 2; ++n) acc[a][b][m][n] = (f32x4){0.f, 0.f, 0.f, 0.f};
        cur = nxt; cA = nA; cB = nB; ++ui;
        if constexpr (ALIGN_EPI) { if (wr == 1) PG8_BAR; }
    }
    PG8_WAIT_V(0);
    if constexpr (!ALIGN_EPI) { if (wr == 0) PG8_BAR; }
    PG8_BAR;
#undef PG8_SA
#undef PG8_SB
#undef PG8_STAGE
#undef PG8_LDA
#undef PG8_LDB
#undef PG8_MMA
#undef PG8_WAIT_V
#undef PG8_WAIT_L
#undef PG8_BAR
#undef PG8_SCHED
}
}

#define GAS __attribute__((address_space(1)))
#define LAS __attribute__((address_space(3)))
typedef unsigned short bf16;
typedef unsigned v4u __attribute__((ext_vector_type(4)));
typedef unsigned v2u __attribute__((ext_vector_type(2)));
typedef float f32x4 __attribute__((ext_vector_type(4)));
typedef float f32x2 __attribute__((ext_vector_type(2)));
typedef short bf16x8 __attribute__((ext_vector_type(8)));
#define LDS_WAIT() asm volatile("s_waitcnt lgkmcnt(0)" ::: "memory")
#define VM_WAIT() asm volatile("s_waitcnt vmcnt(0)" ::: "memory")

__device__ __forceinline__ unsigned f2bf(float f) { unsigned u = __builtin_bit_cast(unsigned, f); return (u + 0x7fffu + ((u >> 16) & 1u)) >> 16; }
__device__ __forceinline__ unsigned pk2(float lo, float hi) { return pg8::cvt_pk_bf16(lo, hi); }
__device__ __forceinline__ float bflo(unsigned w) { return __builtin_bit_cast(float, w << 16); }
__device__ __forceinline__ float bfhi(unsigned w) { return __builtin_bit_cast(float, w & 0xffff0000u); }
__device__ __forceinline__ void unpack8(const v4u w, float (&f)[8]) { f[0] = bflo(w.x); f[1] = bfhi(w.x); f[2] = bflo(w.y); f[3] = bfhi(w.y); f[4] = bflo(w.z); f[5] = bfhi(w.z); f[6] = bflo(w.w); f[7] = bfhi(w.w); }
__device__ __forceinline__ v4u pack8(const float (&f)[8]) { v4u w; w.x = pk2(f[0], f[1]); w.y = pk2(f[2], f[3]); w.z = pk2(f[4], f[5]); w.w = pk2(f[6], f[7]); return w; }
__device__ __forceinline__ float fexp2(float x) { return __builtin_amdgcn_exp2f(x); }
__device__ __forceinline__ float fexp(float x) { return __builtin_amdgcn_exp2f(x * 1.4426950408889634f); }
__device__ __forceinline__ float frcp(float x) { return __builtin_amdgcn_rcpf(x); }
__device__ __forceinline__ float sigmoidf_(float x) { return frcp(1.0f + fexp(-x)); }
__device__ __forceinline__ float siluf_(float x) { return x * sigmoidf_(x); }
__device__ __forceinline__ float tanhf_(float x) { return 1.0f - 2.0f * frcp(1.0f + fexp(2.0f * x)); }
__device__ __forceinline__ float gelu_tanh(float x) { const float u = 1.5957691216057308f * (x + 0.044715f * x * x * x); return x * sigmoidf_(u); }
__device__ __forceinline__ float wave_sum(float v) {
#pragma unroll
    for (int o = 1; o < 64; o <<= 1) v += __shfl_xor(v, o);
    return v;
}
__device__ __forceinline__ int my_tid() { int t = threadIdx.x; asm volatile("" : "+v"(t)); return t; }
__device__ __forceinline__ float dpp_row(float x, const int sel) {
    const int xi = __builtin_bit_cast(int, x); int r;
    if (sel == 0) r = __builtin_amdgcn_update_dpp(0, xi, 0xB1, 0xF, 0xF, true);
    else if (sel == 1) r = __builtin_amdgcn_update_dpp(0, xi, 0x4E, 0xF, 0xF, true);
    else if (sel == 2) r = __builtin_amdgcn_update_dpp(0, xi, 0x141, 0xF, 0xF, true);
    else r = __builtin_amdgcn_update_dpp(0, xi, 0x140, 0xF, 0xF, true);
    return __builtin_bit_cast(float, r);
}
__device__ __forceinline__ float sum16(float x) { x += dpp_row(x, 0); x += dpp_row(x, 1); x += dpp_row(x, 2); x += dpp_row(x, 3); return x; }
__device__ __forceinline__ float dpp_f(float x, const int ctrl_sel) {
    const int xi = __builtin_bit_cast(int, x); int r;
    if (ctrl_sel == 0) r = __builtin_amdgcn_update_dpp(xi, xi, 0xB1, 0xF, 0xF, false);
    else if (ctrl_sel == 1) r = __builtin_amdgcn_update_dpp(xi, xi, 0x4E, 0xF, 0xF, false);
    else r = __builtin_amdgcn_update_dpp(xi, xi, 0x141, 0xF, 0xF, false);
    return __builtin_bit_cast(float, r);
}
__device__ __forceinline__ float sum8(float x) { x += dpp_f(x, 0); x += dpp_f(x, 1); x += dpp_f(x, 2); return x; }

#define XB_TMO      128
#define XB_XCNT(j)  (256  + 64 * (j))
#define XB_XSUB(j)  (1280 + 64 * (j))
#define XB_XGEN(j)  (2304 + 64 * (j))
#define XB_TOP      3328
#define XB_TOPGEN   3392
#define XCD_BAR_WORDS 3456
#define XB_SPIN_CAP (1u << 18)

__device__ __forceinline__ unsigned xb_ld(unsigned* p)              { return __hip_atomic_load(p, __ATOMIC_RELAXED, __HIP_MEMORY_SCOPE_AGENT); }
__device__ __forceinline__ unsigned xb_add(unsigned* p, unsigned v) { return __hip_atomic_fetch_add(p, v, __ATOMIC_RELAXED, __HIP_MEMORY_SCOPE_AGENT); }
__device__ __forceinline__ unsigned xb_xcc_id() { return (unsigned)__builtin_amdgcn_s_getreg((3 << 11) | 20) & 0xFu; }
#define XB_SPIN(cond, bar) do { unsigned _sp = 0; while (cond) { __builtin_amdgcn_s_sleep(1); \
    if ((++_sp & 255u) == 0u) { if (xb_ld(&(bar)[XB_TMO])) break; if (_sp > XB_SPIN_CAP) { atomicAdd(&(bar)[XB_TMO], 1u); break; } } } } while (0)

struct XcdBarrier {
    unsigned* bar; unsigned x;
    volatile LAS unsigned* st;
};
__device__ __forceinline__ XcdBarrier xcd_barrier_post(unsigned* bar, volatile LAS unsigned* st) {
    XcdBarrier b; b.bar = bar; b.x = xb_xcc_id(); b.st = st;
    if (threadIdx.x == 0) (void)xb_add(&bar[XB_XCNT(b.x)], 1u);
    return b;
}
__device__ __forceinline__ void xcd_barrier_complete(unsigned* bar, unsigned x, unsigned& nloc, unsigned& nx) {
    const unsigned G = gridDim.x * gridDim.y * gridDim.z;
    unsigned sum, cnt, mine, sp = 0u;
    for (;;) {
        sum = 0u; cnt = 0u; mine = 0u;
#pragma unroll
        for (unsigned j = 0; j < 16; ++j) { const unsigned c = xb_ld(&bar[XB_XCNT(j)]); sum += c; cnt += (c > 0u) ? 1u : 0u; mine = (j == x) ? c : mine; }
        if (sum == G) break;
        __builtin_amdgcn_s_sleep(1);
        if ((++sp & 255u) == 0u) { if (xb_ld(&bar[XB_TMO])) break; if (sp > XB_SPIN_CAP) { atomicAdd(&bar[XB_TMO], 1u); break; } }
    }
    nloc = mine > 0u ? mine : 1u; nx = cnt > 0u ? cnt : 1u;
}
__device__ __forceinline__ void xcd_barrier(const XcdBarrier& b) {
    asm volatile("s_waitcnt vmcnt(0)" ::: "memory");
    __syncthreads();
    if (threadIdx.x == 0) {
        unsigned* bar = b.bar;
        __builtin_amdgcn_s_waitcnt(0);
        unsigned nloc = b.st[0], nx = b.st[1];
        if (nloc == 0u) { xcd_barrier_complete(bar, b.x, nloc, nx); b.st[0] = nloc; b.st[1] = nx; }
        const unsigned old = xb_add(&bar[XB_XSUB(b.x)], 1u);
        const unsigned gen = old / nloc;
        if (old + 1u == (gen + 1u) * nloc) {
            __builtin_amdgcn_fence(__ATOMIC_RELEASE, "agent");
            asm volatile("s_waitcnt vmcnt(0)" ::: "memory");
            const unsigned og = xb_add(&bar[XB_TOP], 1u);
            const unsigned tg = og / nx;
            if (og + 1u == (tg + 1u) * nx) xb_add(&bar[XB_TOPGEN], 1u);
            else XB_SPIN(xb_ld(&bar[XB_TOPGEN]) == tg, bar);
            __builtin_amdgcn_fence(__ATOMIC_ACQUIRE, "agent");
            xb_add(&bar[XB_XGEN(b.x)], 1u);
            asm volatile("s_waitcnt vmcnt(0)" ::: "memory");
        } else {
            XB_SPIN(xb_ld(&bar[XB_XGEN(b.x)]) == gen, bar);
            __builtin_amdgcn_fence(__ATOMIC_ACQUIRE, "agent");
            asm volatile("s_waitcnt vmcnt(0)" ::: "memory");
        }
    }
    __syncthreads();
}

constexpr int NWAVES = 8, NTHREADS = 512;
constexpr int D = 4096, BATCH = 2, SEQ = 8192, CTXL = 256;
constexpr int MLAT = BATCH * SEQ;
constexpr int MCTX = BATCH * CTXL;
constexpr int MALL = MLAT + MCTX;
constexpr int AB_IN = 13696, ZLD = 13824;
constexpr int ZQ = 0, ZK = 2048, ZV = 2560, ZGA = 3072, ZR = 5120, ZKB = 7168, ZVB = 9216, ZGB = 11264, ZDL = 13312, ZAL = 13504;
constexpr int BW = 2048;
constexpr int CW = 12288;
constexpr int VTLD = SEQ + CTXL;
constexpr int NPHASE = 14;

constexpr size_t MiB = 1u << 20;
constexpr size_t WS_CTL   = 0;
constexpr size_t CTL_ZERO_BYTES = 1 * MiB;
constexpr size_t WS_MODV  = 1 * MiB;
constexpr size_t WS_ROPE  = WS_MODV + 512 * 1024;
constexpr size_t WS_STATS = WS_ROPE + 64 * 1024;
constexpr size_t WS_WSB   = 2 * MiB;
constexpr size_t WS_WLORA = 3 * MiB;
constexpr size_t WS_WOUT0 = 9 * MiB;
constexpr size_t WS_WGOUT = 41 * MiB;
constexpr size_t WS_WGIN  = 137 * MiB;
constexpr size_t WS_H     = 425 * MiB;
constexpr size_t WS_YS    = WS_H;
constexpr size_t WS_X1    = 557 * MiB;
constexpr size_t WS_OAB   = 813 * MiB;
constexpr size_t WS_WIN0  = 941 * MiB;
constexpr size_t WS_VTA   = 1049 * MiB;
constexpr size_t WS_Z     = 1066 * MiB;
constexpr size_t WS_RKVK  = 1512 * MiB;
constexpr size_t WS_EKK   = 1776 * MiB;
constexpr size_t WS_END   = 2172 * MiB;
constexpr size_t WS_Y0    = WS_Z;
constexpr size_t WS_Y1    = WS_Z;
constexpr size_t WS_VT    = WS_Z;
constexpr size_t WS_STATP = WS_RKVK;
constexpr size_t WS_Y     = WS_EKK;
static_assert(WS_WLORA + (size_t)8192 * 384 * 2 <= WS_WOUT0 && WS_WOUT0 + (size_t)D * D * 2 <= WS_WGOUT && WS_WGOUT + (size_t)D * CW * 2 <= WS_WGIN && WS_WGIN + (size_t)3 * CW * D * 2 <= WS_H, "ws map 1");
static_assert(WS_H + (size_t)MALL * D * 2 <= WS_X1 && WS_X1 + (size_t)MLAT * D * 4 <= WS_OAB && WS_OAB + (size_t)MLAT * D * 2 <= WS_WIN0 && WS_WIN0 + (size_t)ZLD * D * 2 <= WS_VTA, "ws map 2");
static_assert(WS_VTA + (size_t)2 * 4 * 128 * VTLD * 2 <= WS_Z && WS_Z + (size_t)MALL * ZLD * 2 <= WS_RKVK && WS_RKVK + (size_t)4 * MALL * BW * 2 <= WS_EKK && WS_EKK + (size_t)6 * MALL * BW * 2 <= WS_END, "ws map 3");
static_assert(WS_VT + (size_t)CW * MLAT * 2 <= WS_RKVK && WS_STATP + (size_t)MLAT * 192 * 8 <= WS_EKK && WS_Y + (size_t)MLAT * CW * 2 <= WS_END && WS_END <= (size_t)2304 * MiB, "ws map 4");
constexpr int CW_BAR = 4096;

constexpr int RING_BYTES = 131072;
constexpr int LDS_BYTES = 147456;
constexpr int LDSCTL_OFF = LDS_BYTES - 256;

struct Args { const float* in[27]; float* out; unsigned char* ws; int ph_lo, ph_hi; };

enum { I_X = 0, I_C, I_CTX, I_CCTX, I_MODW, I_MODB, I_NORMG, I_WIN, I_WOUT, I_SINK, I_CONV, I_W0, I_W2, I_A0, I_A2, I_KK, I_KA, I_RK, I_GNW, I_GNB,
       I_GWIN, I_LNG, I_LNB, I_WS, I_BS, I_GWOUT, I_FING };

__device__ __forceinline__ int src_col(int mat, int c) {
    if (mat == 0) {
        if (c >= ZDL) { const int kind = (c - ZDL) >> 7, r = (c - ZDL) & 127; return r < 96 ? ZDL + kind * 96 + r : -1; }
        if (c < ZV) { const int head = c >> 7, p = c & 127, qq = 4 * (p >> 3) + (p & 3), n = (p >> 2) & 1; return (head << 7) + qq + (qq >= 32 ? 32 : 0) + 32 * n; }
        return c;
    }
    if (mat == 2) {
        if (c < CW) return CW + c;
        const int cc = c - CW, tile = cc >> 8, w = cc & 255;
        return w < 128 ? (tile * 128 + w) : (2 * CW + tile * 128 + (w - 128));
    }
    return c;
}
__device__ __forceinline__ void tr_load(const float* W, int N, int mat, int item, int lane, int nblk, float (&x)[32]) {
    const int kb = item / nblk, nb = item % nblk, k0 = 64 * kb, n0 = 32 * nb;
    const int sc = src_col(mat, n0 + (lane & 31));
#pragma unroll
    for (int i = 0; i < 32; ++i) { const int kk = 2 * i + (lane >> 5); x[i] = sc >= 0 ? W[(size_t)(k0 + kk) * N + sc] : 0.f; }
}
__device__ __forceinline__ void tr_load_nc(const float* W, int N, int mat, int item, int lane, int nblk, float (&x)[32]) {
    const int kb = item / nblk, nb = item % nblk, k0 = 64 * kb, n0 = 32 * nb;
    const int sc = src_col(mat, n0 + (lane & 31));
    const float* wp = W + (size_t)(k0 + (lane >> 5)) * N + sc;
#pragma unroll
    for (int i = 0; i < 32; ++i) x[i] = wp[(size_t)(2 * i) * N];
}
__device__ __forceinline__ void tr_store(bf16* WT, int K, LAS float* scr, int item, int lane, int nblk, const float (&x)[32]) {
    const int kb = item / nblk, nb = item % nblk, k0 = 64 * kb, n0 = 32 * nb;
#pragma unroll
    for (int i = 0; i < 32; ++i) { const int kk = 2 * i + (lane >> 5); scr[kk * 33 + (lane & 31)] = x[i]; }
    LDS_WAIT(); asm volatile("" ::: "memory");
    const int c = lane & 7;
#pragma unroll
    for (int j = 0; j < 4; ++j) { const int n = (lane >> 3) + 8 * j; const LAS float* s = scr + (8 * c) * 33 + n;
        v4u o; o.x = pk2(s[0 * 33], s[1 * 33]); o.y = pk2(s[2 * 33], s[3 * 33]); o.z = pk2(s[4 * 33], s[5 * 33]); o.w = pk2(s[6 * 33], s[7 * 33]);
        *(GAS v4u*)(WT + (size_t)(n0 + n) * K + k0 + 8 * c) = o; }
    LDS_WAIT(); asm volatile("" ::: "memory");
}
__device__ __forceinline__ void p0_transpose_item(const float* W, int K, int N, bf16* WT, int mat, LAS float* scr, int item, int lane, int nblk) {
    float x[32]; tr_load(W, N, mat, item, lane, nblk, x); tr_store(WT, K, scr, item, lane, nblk, x);
}
constexpr int TR_NB0 = ZLD / 32, TR_NB1 = D / 32, TR_NB2 = 3 * CW / 32, TR_NB3 = D / 32;
constexpr int L1_P5 = 28672;
constexpr int ATT_P5 = 1024;
constexpr int TR_I0 = (D / 64) * TR_NB0, TR_I1 = (D / 64) * TR_NB1, TR_I2 = (D / 64) * TR_NB2, TR_I3 = (CW / 64) * TR_NB3;
__device__ __forceinline__ void l1_load(const Args& a, int j, int lane, float (&x)[32]) {
    if (j < TR_I2) tr_load(a.in[I_GWIN], 3 * CW, 2, j, lane, TR_NB2, x); else tr_load(a.in[I_GWOUT], D, 3, j - TR_I2, lane, TR_NB3, x);
}
__device__ __forceinline__ void l1_store(const Args& a, int j, int lane, LAS float* scr, const float (&x)[32]) {
    if (j < TR_I2) tr_store((bf16*)(a.ws + WS_WGIN), D, scr, j, lane, TR_NB2, x); else tr_store((bf16*)(a.ws + WS_WGOUT), CW, scr, j - TR_I2, lane, TR_NB3, x);
}
__device__ __forceinline__ void p0_phase(const Args& a, LAS unsigned char* lds) {
    const int tid = my_tid(), lane = tid & 63, wave = __builtin_amdgcn_readfirstlane(tid >> 6);
    unsigned char* ws = a.ws;
    const int G = gridDim.x, bx = blockIdx.x;
    {
        LAS float* sc = (LAS float*)lds;
        LAS float* red = (LAS float*)(lds + 49152);
        for (int i = tid; i < 3 * D; i += NTHREADS) { const int j = i / D, k = i % D; const float v = j < 2 ? a.in[I_C][j * D + k] : a.in[I_CCTX][k]; sc[i] = siluf_(v); }
        __syncthreads();
        float* modv = (float*)(ws + WS_MODV);
        for (int item = bx; item < 256; item += G) {
            const int l = item >> 7, cb = (item & 127) * 96;
            const float* W = a.in[I_MODW] + (size_t)l * D * 3 * D;
            if (tid < 384) {
                const int cg = tid % 24, ks = tid / 24;
                f32x4 a0 = {0.f, 0.f, 0.f, 0.f}, a1 = a0, a2 = a0;
                const float* wp = W + (size_t)(ks * 256) * (3 * D) + cb + 4 * cg;
#pragma unroll 32
                for (int r = 0; r < 256; ++r) {
                    const f32x4 w = *(const GAS f32x4*)(wp + (size_t)r * (3 * D));
                    const int k = ks * 256 + r;
                    a0 += w * sc[k]; a1 += w * sc[D + k]; a2 += w * sc[2 * D + k];
                }
                LAS float* rp = red + (ks * 24 + cg) * 12;
                *(LAS f32x4*)(rp) = a0; *(LAS f32x4*)(rp + 4) = a1; *(LAS f32x4*)(rp + 8) = a2;
            }
            __syncthreads();
            if (tid < 288) {
                const int j = tid / 96, col = tid % 96, cg = col >> 2, e = col & 3;
                float s = 0.f;
#pragma unroll
                for (int ks = 0; ks < 16; ++ks) s += red[(ks * 24 + cg) * 12 + j * 4 + e];
                modv[((size_t)l * 3 + j) * (3 * D) + cb + col] = s + a.in[I_MODB][(size_t)l * 3 * D + cb + col];
            }
            __syncthreads();
        }
    }
    {
        LAS float* scr = (LAS float*)(lds + wave * 16384);
        const int gw = bx * NWAVES + wave, NGW = G * NWAVES;
        constexpr int P0_ITEMS = TR_I0 + TR_I1 + (TR_I2 + TR_I3 - L1_P5);
        auto p0_load = [&](int it, float (&x)[32]) { if (it < TR_I0) tr_load(a.in[I_WIN], AB_IN, 0, it, lane, TR_NB0, x); else if (it < TR_I0 + TR_I1) tr_load(a.in[I_WOUT], D, 1, it - TR_I0, lane, TR_NB1, x); else l1_load(a, it - TR_I0 - TR_I1 + L1_P5, lane, x); };
        auto p0_store = [&](int it, const float (&x)[32]) { if (it < TR_I0) tr_store((bf16*)(ws + WS_WIN0), D, scr, it, lane, TR_NB0, x); else if (it < TR_I0 + TR_I1) tr_store((bf16*)(ws + WS_WOUT0), D, scr, it - TR_I0, lane, TR_NB1, x); else l1_store(a, it - TR_I0 - TR_I1 + L1_P5, lane, scr, x); };
        float x[32], xn[32];
        int it = gw;
        if (it < P0_ITEMS) p0_load(it, x);
        while (it < P0_ITEMS) {
            const int itn = it + NGW;
            if (itn < P0_ITEMS) p0_load(itn, xn);
            p0_store(it, x);
#pragma unroll
            for (int i = 0; i < 32; ++i) x[i] = xn[i];
            it = itn;
        }
    }
    {
        const size_t gt = (size_t)bx * NTHREADS + tid, GT = (size_t)G * NTHREADS;
        bf16* wl = (bf16*)(ws + WS_WLORA);
        for (size_t i = gt; i < (size_t)8192 * 128; i += GT) {
            const int n = (int)(i >> 7), r = (int)(i & 127), kind = n >> 11, c = n & 2047, dir = kind & 1;
            float v = 0.f;
            if (r < 96) { const float* src = (kind < 2) ? a.in[I_W2] : a.in[I_A2]; v = src[((size_t)dir * 96 + r) * BW + c]; }
            wl[i] = (bf16)f2bf(v);
        }
        bf16* wsb = (bf16*)(ws + WS_WSB);
        for (size_t i = gt; i < (size_t)16 * 128 * 128; i += GT) wsb[i] = (bf16)f2bf(a.in[I_WS][i]);
        float* rope = (float*)(ws + WS_ROPE);
        for (size_t i = gt; i < (size_t)128 * 32; i += GT) {
            const int pos = (int)(i >> 5), f = (int)(i & 31);
            const float inv = powf(10000.0f, -(float)f / 32.0f); const float ang = (float)pos * inv;
            rope[i] = cosf(ang); rope[4096 + i] = sinf(ang);
        }
    }
}

__device__ __forceinline__ void norm_phase(const Args& a, LAS unsigned char* lds, int layer, const float* xlat, const float* xctx, int nrows, const bf16* yadd, bf16* xout) {
    const int tid = my_tid(), lane = tid & 63, wave = __builtin_amdgcn_readfirstlane(tid >> 6);
    LAS float* gs = (LAS float*)lds; LAS float* sh = (LAS float*)(lds + 49152);
    const float* modv = (const float*)(a.ws + WS_MODV) + (size_t)layer * 3 * 3 * D;
    const float* g = a.in[I_NORMG] + (size_t)layer * D;
#pragma unroll 8
    for (int i = tid; i < 3 * D; i += NTHREADS) { const int j = i / D, k = i % D; gs[i] = g[k] * (1.0f + modv[(size_t)j * 3 * D + D + k]); sh[i] = modv[(size_t)j * 3 * D + k]; }
    __syncthreads();
    bf16* H = (bf16*)(a.ws + WS_H);
    const int gw = blockIdx.x * NWAVES + wave, NGW = gridDim.x * NWAVES;
    f32x4 v[16], vn[16]; v2u yv[16], yn[16];
    auto loadrow = [&](int row, f32x4 (&dst)[16], v2u (&yd)[16]) {
        const float* xr = (row < MLAT) ? xlat + (size_t)row * D : xctx + (size_t)(row - MLAT) * D;
        const GAS f32x4* xp = (const GAS f32x4*)xr + lane;
#pragma unroll
        for (int q = 0; q < 16; ++q) dst[q] = xp[64 * q];
        if (yadd) { const GAS v2u* yp = (const GAS v2u*)(yadd + (size_t)row * D) + lane;
#pragma unroll
            for (int q = 0; q < 16; ++q) yd[q] = yp[64 * q]; }
    };
    int row = gw;
    if (row < nrows) loadrow(row, v, yv);
    while (row < nrows) {
        const int nrow = row + NGW;
        if (nrow < nrows) loadrow(nrow, vn, yn);
        const int j = (row < MLAT) ? (row >> 13) : 2;
        float s = 0.f;
        if (yadd) {
            GAS v2u* xo = (GAS v2u*)(xout + (size_t)row * D) + lane;
#pragma unroll
            for (int q = 0; q < 16; ++q) { v[q] += (f32x4){bflo(yv[q].x), bfhi(yv[q].x), bflo(yv[q].y), bfhi(yv[q].y)}; v2u w; w.x = pk2(v[q].x, v[q].y); w.y = pk2(v[q].z, v[q].w); xo[64 * q] = w; }
        }
#pragma unroll
        for (int q = 0; q < 16; ++q) s += (v[q].x * v[q].x + v[q].y * v[q].y) + (v[q].z * v[q].z + v[q].w * v[q].w);
        const float rstd = 1.0f / sqrtf(wave_sum(s) * (1.0f / D) + 1e-6f);
        GAS v2u* op = (GAS v2u*)(H + (size_t)row * D) + lane;
#pragma unroll
        for (int q = 0; q < 16; ++q) {
            const int c = 4 * lane + 256 * q;
            const f32x4 gg = *(const LAS f32x4*)(gs + j * D + c), ss = *(const LAS f32x4*)(sh + j * D + c);
            const f32x4 o = v[q] * rstd * gg + ss;
            v2u w; w.x = pk2(o.x, o.y); w.y = pk2(o.z, o.w); op[64 * q] = w;
        }
#pragma unroll
        for (int q = 0; q < 16; ++q) { v[q] = vn[q]; yv[q] = yn[q]; }
        row = nrow;
    }
}

typedef pg8::f32x4 af4;
struct EpiNull { static constexpr bool PERM = true; __device__ __forceinline__ void operator()(const af4 (&acc)[2][2][4][2], const pg8::Unit& u, int wr, int wc, int fr, int fq) const {
    af4 s = {0.f, 0.f, 0.f, 0.f};
#pragma unroll
    for (int a = 0; a < 2; ++a)
#pragma unroll
        for (int b = 0; b < 2; ++b)
#pragma unroll
            for (int m = 0; m < 4; ++m)
#pragma unroll
                for (int n = 0; n < 2; ++n) s += acc[a][b][m][n];
    if (s[0] + s[1] + s[2] + s[3] == 123.456f) *(GAS float*)nullptr = 0.f; } };
struct EpiZ {
    static constexpr bool PERM = true;
    bf16* Z; bf16* VTA; const float* rope;
    __device__ __forceinline__ void operator()(const af4 (&acc)[2][2][4][2], const pg8::Unit& u, int wr, int wc, int fr, int fq) const {
        const int pn = u.pn, row0 = u.pm * 256 + wr * 64 + fr, col0 = pn * 256 + wc * 32 + 8 * fq;
        if (pn < 10 && u.pm < 64) {
            const float qs = (pn < 8) ? 0.08838834764831845f * 1.4426950408889634f : 1.0f;
            const int fbase = 16 * (wc & 1) + 4 * fq;
#pragma unroll
            for (int ai = 0; ai < 2; ++ai)
#pragma unroll
                for (int m = 0; m < 4; ++m) {
                    const int row = row0 + ai * 128 + m * 16, t = row & (SEQ - 1), pos = (wc < 2) ? (t >> 6) : (t & 63);
                    const af4 cs = *(const GAS af4*)(rope + pos * 32 + fbase), sn = *(const GAS af4*)(rope + 4096 + pos * 32 + fbase);
                    bf16* rowp = Z + (size_t)row * ZLD + col0;
#pragma unroll
                    for (int bj = 0; bj < 2; ++bj) {
                        const af4 x1 = acc[ai][bj][m][0], x2 = acc[ai][bj][m][1];
                        const af4 o1 = (x1 * cs - x2 * sn) * qs, o2 = (x2 * cs + x1 * sn) * qs;
                        v4u w; w.x = pk2(o1[0], o1[1]); w.y = pk2(o1[2], o1[3]); w.z = pk2(o2[0], o2[1]); w.w = pk2(o2[2], o2[3]);
                        *(GAS v4u*)(rowp + bj * 128) = w;
                    }
                }
        } else if (pn == 10 || pn == 11) {
#pragma unroll
            for (int ai = 0; ai < 2; ++ai)
#pragma unroll
                for (int m = 0; m < 4; ++m) {
                    const int row = row0 + ai * 128 + m * 16;
                    int b, tpos;
                    if (row < MLAT) { b = row >> 13; tpos = row & (SEQ - 1); } else { const int rr = row - MLAT; b = rr >> 8; tpos = SEQ + (rr & 255); }
                    const int k32 = tpos & 31, sp = (tpos & ~31) + ((k32 < 16) ? (8 * (k32 >> 2) + (k32 & 3)) : (8 * ((k32 - 16) >> 2) + 4 + (k32 & 3)));
#pragma unroll
                    for (int bj = 0; bj < 2; ++bj) {
                        const int hk = (pn - 10) * 2 + bj;
                        bf16* vp = VTA + ((size_t)(b * 4 + hk) * 128 + wc * 32 + 8 * fq) * VTLD + sp;
#pragma unroll
                        for (int n = 0; n < 2; ++n)
#pragma unroll
                            for (int e = 0; e < 4; ++e) vp[(size_t)(4 * n + e) * VTLD] = (bf16)f2bf(acc[ai][bj][m][n][e]);
                    }
                }
        } else {
            const bool th0 = (pn == 52), th1 = (pn == 52);
#pragma unroll
            for (int ai = 0; ai < 2; ++ai)
#pragma unroll
                for (int m = 0; m < 4; ++m) {
                    bf16* rowp = Z + (size_t)(row0 + ai * 128 + m * 16) * ZLD + col0;
#pragma unroll
                    for (int bj = 0; bj < 2; ++bj) {
                        af4 v0 = acc[ai][bj][m][0], v1 = acc[ai][bj][m][1];
                        if (bj == 0 ? th0 : th1) {
#pragma unroll
                            for (int e = 0; e < 4; ++e) { v0[e] = tanhf_(v0[e]); v1[e] = tanhf_(v1[e]); }
                        }
                        v4u w; w.x = pk2(v0[0], v0[1]); w.y = pk2(v0[2], v0[3]); w.z = pk2(v1[0], v1[1]); w.w = pk2(v1[2], v1[3]);
                        *(GAS v4u*)(rowp + bj * 128) = w;
                    }
                }
        }
    }
};
struct EpiLora {
    static constexpr bool PERM = true;
    const float *w0, *a0; bf16 *EA;
    __device__ __forceinline__ void operator()(const af4 (&acc)[2][2][4][2], const pg8::Unit& u, int wr, int wc, int fr, int fq) const {
        const int kind = u.pn >> 3, dir = kind & 1, cb = (u.pn & 7) * 256 + wc * 32 + 8 * fq, row0 = u.pm * 256 + wr * 64 + fr;
        const float* bias = (kind < 2 ? w0 : a0) + dir * BW;
        const float sc = kind < 2 ? 0.6065306597126334f * 1.4426950408889634f : 1.0f;
#pragma unroll
        for (int bj = 0; bj < 2; ++bj) {
            const int c = cb + bj * 128;
            const af4 bb[2] = {*(const GAS af4*)(bias + c) * -1.4426950408889634f, *(const GAS af4*)(bias + c + 4) * -1.4426950408889634f};
#pragma unroll
            for (int ai = 0; ai < 2; ++ai)
#pragma unroll
                for (int m = 0; m < 4; ++m) {
                    const int row = row0 + ai * 128 + m * 16;
                    float o[8];
#pragma unroll
                    for (int n = 0; n < 2; ++n)
#pragma unroll
                        for (int e = 0; e < 4; e += 2) {
                            const f32x2 x = {acc[ai][bj][m][n][e], acc[ai][bj][m][n][e + 1]};
                            const f32x2 ar = x * -1.4426950408889634f + (f32x2){bb[n][e], bb[n][e + 1]};
                            const f32x2 den = (f32x2){fexp2(ar.x), fexp2(ar.y)} + 1.0f;
                            const f32x2 r = (f32x2){frcp(den.x), frcp(den.y)} * sc;
                            o[4 * n + e] = r.x; o[4 * n + e + 1] = r.y; }
                    *(GAS v4u*)(EA + ((size_t)kind * MALL + row) * BW + c) = pack8(o);
                }
        }
    }
};
struct EpiGateOut {
    static constexpr bool PERM = true;
    bf16* Y; const float* gate;
    __device__ __forceinline__ void operator()(const af4 (&acc)[2][2][4][2], const pg8::Unit& u, int wr, int wc, int fr, int fq) const {
        const int row0 = u.pm * 256 + wr * 64 + fr, col0 = u.pn * 256 + wc * 32 + 8 * fq;
        const float* gp = gate + (size_t)(u.pm >> 5) * 3 * D + col0;
        af4 gv[2][2];
#pragma unroll
        for (int bj = 0; bj < 2; ++bj)
#pragma unroll
            for (int n = 0; n < 2; ++n) gv[bj][n] = *(const GAS af4*)(gp + bj * 128 + n * 4);
#pragma unroll
        for (int ai = 0; ai < 2; ++ai)
#pragma unroll
            for (int m = 0; m < 4; ++m) {
                bf16* rowp = Y + (size_t)(row0 + ai * 128 + m * 16) * D + col0;
#pragma unroll
                for (int bj = 0; bj < 2; ++bj) {
                    const af4 v0 = acc[ai][bj][m][0] * gv[bj][0], v1 = acc[ai][bj][m][1] * gv[bj][1];
                    v4u w; w.x = pk2(v0[0], v0[1]); w.y = pk2(v0[2], v0[3]); w.z = pk2(v1[0], v1[1]); w.w = pk2(v1[2], v1[3]);
                    *(GAS v4u*)(rowp + bj * 128) = w;
                }
            }
    }
};
struct EpiVT {
    static constexpr bool PERM = true;
    bf16* VT; float* statp;
    __device__ __forceinline__ void operator()(const af4 (&acc)[2][2][4][2], const pg8::Unit& u, int wr, int wc, int fr, int fq) const {
        const int row0 = u.pm * 256 + wr * 64 + fr, col0 = u.pn * 256 + wc * 32 + 8 * fq;
#pragma unroll
        for (int bj = 0; bj < 2; ++bj) {
            f32x2 p1[4], p2[4];
#pragma unroll
            for (int i = 0; i < 4; ++i) { p1[i] = (f32x2){0.f, 0.f}; p2[i] = (f32x2){0.f, 0.f}; }
#pragma unroll
            for (int ai = 0; ai < 2; ++ai)
#pragma unroll
                for (int m = 0; m < 4; ++m) {
                    float o[8];
#pragma unroll
                    for (int n = 0; n < 2; ++n)
#pragma unroll
                        for (int e = 0; e < 4; e += 2) {
                            const f32x2 x = {acc[ai][bj][m][n][e], acc[ai][bj][m][n][e + 1]};
                            const f32x2 ar = x * (x * x * (-2.302208198f * 0.044715f) + (-2.302208198f));
                            const f32x2 den = (f32x2){fexp2(ar.x), fexp2(ar.y)} + 1.0f;
                            const f32x2 gv = x * (f32x2){frcp(den.x), frcp(den.y)};
                            o[4 * n + e] = gv.x; o[4 * n + e + 1] = gv.y; p1[2 * n + (e >> 1)] += gv; p2[2 * n + (e >> 1)] += gv * gv; }
                    *(GAS v4u*)(VT + (size_t)(row0 + ai * 128 + m * 16) * MLAT + col0 + bj * 128) = pack8(o);
                }
            float s1[8], s2[8];
#pragma unroll
            for (int i = 0; i < 4; ++i) { s1[2 * i] = p1[i].x; s1[2 * i + 1] = p1[i].y; s2[2 * i] = p2[i].x; s2[2 * i + 1] = p2[i].y; }
#pragma unroll
            for (int e = 0; e < 8; ++e) { s1[e] = sum16(s1[e]); s2[e] = sum16(s2[e]); }
            if (fr == 0) {
#pragma unroll
                for (int e = 0; e < 8; ++e) *(GAS f32x2*)(statp + ((size_t)(col0 + bj * 128 + e) * 96 + u.pm * 2 + wr) * 2) = (f32x2){s1[e], s2[e]};
            }
            asm volatile("" ::: "memory");
        }
    }
};
struct EpiGate {
    static constexpr bool PERM = true;
    const bf16* VT; const float* stats; const bf16* wsb; const float *bs, *lng, *lnb; bf16* Y;
    __device__ __forceinline__ void operator()(const af4 (&acc)[2][2][4][2], const pg8::Unit& u, int wr_, int wc_, int fr_, int fq_) const {
        const int tid = my_tid(), lane = tid & 63, wid = __builtin_amdgcn_readfirstlane(tid >> 6), wr = wid >> 2, wc = wid & 3, fr = lane & 15, fq = lane >> 4;
        (void)wr_; (void)wc_; (void)fr_; (void)fq_;
        const int chbase = u.pn * 128, grp = u.pn / 6;
        const bf16* wsg = wsb + (size_t)grp * 128 * 128;
        const int chl = chbase + 32 * wc + 8 * (fr >> 2) + (fr & 3);
        float lg[2], lb[2];
#pragma unroll
        for (int n = 0; n < 2; ++n) { lg[n] = lng[chl + 4 * n]; lb[n] = lnb[chl + 4 * n]; }
        v4u raw[2][4];
        auto load_raw = [&](int ai) {
#pragma unroll
            for (int ks = 0; ks < 4; ++ks)
#pragma unroll
                for (int n = 0; n < 2; ++n) raw[n][ks] = *(const GAS v4u*)(VT + (size_t)(chl + 4 * n) * MLAT + u.pm * 256 + ai * 128 + 32 * ks + 8 * fq);
        };
        load_raw(0);
#pragma unroll
        for (int ai = 0; ai < 2; ++ai) {
            const int tok0 = u.pm * 256 + ai * 128;
            bf16x8 av[2][4];
#pragma unroll
            for (int ks = 0; ks < 4; ++ks) {
                const int j0 = tok0 + 32 * ks + 8 * fq;
                f32x4 st[4];
#pragma unroll
                for (int q = 0; q < 4; ++q) st[q] = *(const GAS f32x4*)(stats + (size_t)(j0 + 2 * q) * 2);
#pragma unroll
                for (int n = 0; n < 2; ++n) {
                    float vf[8];
                    unpack8(raw[n][ks], vf);
#pragma unroll
                    for (int q = 0; q < 4; ++q) { f32x2 t = {vf[2 * q], vf[2 * q + 1]}; t = t * (f32x2){st[q].z, st[q].w} + (f32x2){st[q].x, st[q].y}; t = t * lg[n] + lb[n]; vf[2 * q] = t.x; vf[2 * q + 1] = t.y; }
                    av[n][ks] = __builtin_bit_cast(bf16x8, pack8(vf));
                }
            }
#pragma unroll
            for (int m = 0; m < 4; ++m) {
                if (ai == 0 && m == 0) load_raw(1);
                const int it = wr * 64 + m * 16 + fr;
                bf16x8 wf[4];
#pragma unroll
                for (int ks = 0; ks < 4; ++ks) wf[ks] = *(const GAS bf16x8*)(wsg + (size_t)it * 128 + 32 * ks + 8 * fq);
                const float bsi = bs[grp * 128 + it];
                af4 vm[2] = {(af4){bsi, bsi, bsi, bsi}, (af4){bsi, bsi, bsi, bsi}};
#pragma unroll
                for (int ks = 0; ks < 4; ++ks) {
#pragma unroll
                    for (int n = 0; n < 2; ++n) vm[n] = __builtin_amdgcn_mfma_f32_16x16x32_bf16(av[n][ks], wf[ks], vm[n], 0, 0, 0);
                }
                float o[8];
#pragma unroll
                for (int n = 0; n < 2; ++n)
#pragma unroll
                    for (int e = 0; e < 4; e += 2) {
                        const f32x2 uu = {acc[ai][0][m][n][e], acc[ai][0][m][n][e + 1]}, gg = {acc[ai][1][m][n][e], acc[ai][1][m][n][e + 1]}, vv = {vm[n][e], vm[n][e + 1]};
                        const f32x2 ar = uu * (uu * uu * (-2.302208198f * 0.044715f) + (-2.302208198f));
                        const f32x2 gs = gg * (-1.4426950408889634f);
                        const f32x2 ea = {fexp2(ar.x), fexp2(ar.y)}, eb = {fexp2(gs.x), fexp2(gs.y)};
                        const f32x2 q = eb + 1.0f, den = ea * q + q;
                        const f32x2 r = {frcp(den.x), frcp(den.y)};
                        const f32x2 w = (uu * gg) * vv * r;
                        o[4 * n + e] = w.x; o[4 * n + e + 1] = w.y; }
                *(GAS v4u*)(Y + (size_t)(tok0 + it) * CW + chbase + 32 * wc + 8 * fq) = pack8(o);
            }
        }
        (void)lane;
    }
};

constexpr int AK_STRIDE = 320, AV_STRIDE = 192, AK_BYTES = 64 * AK_STRIDE, AV_BYTES = 128 * AV_STRIDE, ATT_BUF = AK_BYTES + AV_BYTES;
__device__ __forceinline__ void attn_unit(const Args& a, LAS unsigned char* lds, int unit, int tid, int lane, int wave) {
    const bf16* Z = (const bf16*)(a.ws + WS_Z); const bf16* VTA = (const bf16*)(a.ws + WS_VTA); bf16* OAB = (bf16*)(a.ws + WS_OAB);
    const int hp = unit & 1, hk = (unit >> 1) & 3, nblk = (unit >> 3) & 63, b = unit >> 9;
    const int hq = 4 * hk + 2 * hp + (wave >> 2), qoff = 32 * (wave & 3);
    const int c16 = lane & 15, g = lane >> 4;
    bf16x8 qf[2][4];
#pragma unroll
    for (int qt = 0; qt < 2; ++qt) {
        const size_t row = (size_t)b * SEQ + nblk * 128 + qoff + 16 * qt + c16;
#pragma unroll
        for (int ks = 0; ks < 4; ++ks) qf[qt][ks] = *(const GAS bf16x8*)(Z + row * ZLD + ZQ + hq * 128 + 32 * ks + 8 * g);
    }
    const float sinkl2 = a.in[I_SINK][hq] * 1.4426950408889634f;
    float mrun[2] = {sinkl2, sinkl2}, lpart[2] = {0.f, 0.f};
    af4 O[2][8];
#pragma unroll
    for (int qt = 0; qt < 2; ++qt)
#pragma unroll
        for (int dt = 0; dt < 8; ++dt) O[qt][dt] = (af4){0.f, 0.f, 0.f, 0.f};
    const bf16* vtb = VTA + (size_t)(b * 4 + hk) * 128 * VTLD;
    auto step_valid = [&](int st) -> bool { if (st < 4) return true; const int nb = nblk - 1 + ((st - 4) >> 1); return nb >= 0 && nb <= 63; };
    auto step_geo = [&](int st, int& krow0, int& tpos0, int& kk0) {
        if (st < 4) { krow0 = MLAT + b * CTXL + 64 * st; tpos0 = SEQ + 64 * st; kk0 = 0; }
        else { const int bi = (st - 4) >> 1, hf = (st - 4) & 1, nb = nblk - 1 + bi; krow0 = b * SEQ + nb * 128 + 64 * hf; tpos0 = nb * 128 + 64 * hf; kk0 = bi * 128 + 64 * hf; } };
    v4u pk0, pk1, pv0, pv1;
    auto issue = [&](int st) { int krow0, tpos0, kk0; step_geo(st, krow0, tpos0, kk0);
        const bf16* kp = Z + (size_t)(krow0 + (tid >> 3)) * ZLD + ZK + hk * 128 + 8 * (tid & 7);
        pk0 = *(const GAS v4u*)kp; pk1 = *(const GAS v4u*)(kp + 64);
        const bf16* vp = vtb + (size_t)(tid >> 2) * VTLD + tpos0 + 8 * (tid & 3);
        pv0 = *(const GAS v4u*)vp; pv1 = *(const GAS v4u*)(vp + 32); };
    auto commit = [&](int bufi) { LAS unsigned char* kb = lds + bufi * ATT_BUF; LAS unsigned char* vb = kb + AK_BYTES;
        *(LAS v4u*)(kb + (tid >> 3) * AK_STRIDE + 16 * (tid & 7)) = pk0; *(LAS v4u*)(kb + (tid >> 3) * AK_STRIDE + 16 * (tid & 7) + 128) = pk1;
        *(LAS v4u*)(vb + (tid >> 2) * AV_STRIDE + 16 * (tid & 3)) = pv0; *(LAS v4u*)(vb + (tid >> 2) * AV_STRIDE + 16 * (tid & 3) + 64) = pv1; };
    int st = 0, bufi = 0;
    issue(0); commit(0);
    asm volatile("s_waitcnt lgkmcnt(0)" ::: "memory"); __builtin_amdgcn_s_barrier(); asm volatile("" ::: "memory");
    while (st < 10) {
        int nst = st + 1; while (nst < 10 && !step_valid(nst)) ++nst;
        if (nst < 10) issue(nst);
        int krow0, tpos0, kk0; step_geo(st, krow0, tpos0, kk0);
        const bool band = st >= 4;
        const bool live = !band || !(kk0 + 63 < qoff || kk0 > qoff + 31 + 256);
        if (live) {
        const LAS unsigned char* kb = lds + bufi * ATT_BUF; const LAS unsigned char* vb = kb + AK_BYTES;
        af4 S[2][4];
#pragma unroll
        for (int t4 = 0; t4 < 4; ++t4) {
            bf16x8 kf[4];
#pragma unroll
            for (int ks = 0; ks < 4; ++ks) kf[ks] = *(const LAS bf16x8*)(kb + (16 * t4 + c16) * AK_STRIDE + (32 * ks + 8 * g) * 2);
#pragma unroll
            for (int qt = 0; qt < 2; ++qt) {
                af4 sacc = (af4){0.f, 0.f, 0.f, 0.f};
#pragma unroll
                for (int ks = 0; ks < 4; ++ks) sacc = __builtin_amdgcn_mfma_f32_16x16x32_bf16(kf[ks], qf[qt][ks], sacc, 0, 0, 0);
                S[qt][t4] = sacc;
            }
        }
        bf16x8 pf[2][2];
#pragma unroll
        for (int qt = 0; qt < 2; ++qt) {
            if (band) {
                const int qi = qoff + 16 * qt + c16;
#pragma unroll
                for (int t4 = 0; t4 < 4; ++t4)
#pragma unroll
                    for (int r = 0; r < 4; ++r) { const int kk = kk0 + 16 * t4 + 4 * g + r; if (kk < qi || kk > qi + 256) S[qt][t4][r] = -INFINITY; }
            }
            float mx = S[qt][0][0];
#pragma unroll
            for (int t4 = 0; t4 < 4; ++t4)
#pragma unroll
                for (int r = 0; r < 4; ++r) mx = fmaxf(mx, S[qt][t4][r]);
            mx = fmaxf(mx, __shfl_xor(mx, 16)); mx = fmaxf(mx, __shfl_xor(mx, 32));
            const float mnew = fmaxf(mrun[qt], mx), alpha = fexp2(mrun[qt] - mnew);
            mrun[qt] = mnew;
            float ps = 0.f;
#pragma unroll
            for (int t4 = 0; t4 < 4; ++t4)
#pragma unroll
                for (int r = 0; r < 4; ++r) { const float p = fexp2(S[qt][t4][r] - mnew); S[qt][t4][r] = p; ps += p; }
            lpart[qt] = lpart[qt] * alpha + ps;
#pragma unroll
            for (int dt = 0; dt < 8; ++dt) O[qt][dt] *= alpha;
#pragma unroll
            for (int k2 = 0; k2 < 2; ++k2) {
                v4u w; w.x = pk2(S[qt][2 * k2][0], S[qt][2 * k2][1]); w.y = pk2(S[qt][2 * k2][2], S[qt][2 * k2][3]);
                w.z = pk2(S[qt][2 * k2 + 1][0], S[qt][2 * k2 + 1][1]); w.w = pk2(S[qt][2 * k2 + 1][2], S[qt][2 * k2 + 1][3]);
                pf[qt][k2] = __builtin_bit_cast(bf16x8, w);
            }
        }
#pragma unroll
        for (int dt = 0; dt < 8; ++dt) {
#pragma unroll
            for (int k2 = 0; k2 < 2; ++k2) {
                const bf16x8 vf = *(const LAS bf16x8*)(vb + (16 * dt + c16) * AV_STRIDE + (32 * k2 + 8 * g) * 2);
#pragma unroll
                for (int qt = 0; qt < 2; ++qt) O[qt][dt] = __builtin_amdgcn_mfma_f32_16x16x32_bf16(vf, pf[qt][k2], O[qt][dt], 0, 0, 0);
            }
        }
        }
        if (nst < 10) commit(bufi ^ 1);
        asm volatile("s_waitcnt lgkmcnt(0)" ::: "memory"); __builtin_amdgcn_s_barrier(); asm volatile("" ::: "memory");
        bufi ^= 1; st = nst;
    }
#pragma unroll
    for (int qt = 0; qt < 2; ++qt) {
        float L = lpart[qt]; L += __shfl_xor(L, 16); L += __shfl_xor(L, 32);
        L += fexp2(sinkl2 - mrun[qt]);
        const float inv = 1.0f / L;
        const size_t row = (size_t)b * SEQ + nblk * 128 + qoff + 16 * qt + c16;
#pragma unroll
        for (int dt = 0; dt < 8; ++dt) {
            const int d = 16 * dt + 4 * g;
            const v2u gw = *(const GAS v2u*)(Z + row * ZLD + ZGA + hq * 128 + d);
            const float g0 = bflo(gw.x), g1 = bfhi(gw.x), g2 = bflo(gw.y), g3 = bfhi(gw.y);
            v2u w; w.x = pk2(O[qt][dt][0] * inv * siluf_(g0), O[qt][dt][1] * inv * siluf_(g1)); w.y = pk2(O[qt][dt][2] * inv * siluf_(g2), O[qt][dt][3] * inv * siluf_(g3));
            *(GAS v2u*)(OAB + row * D + hq * 128 + d) = w;
        }
    }
}

__device__ __forceinline__ void prep_load_row(const bf16* Z, int row, int c, v4u (&z)[3]) {
#pragma unroll
    for (int qn = 0; qn < 3; ++qn) z[qn] = *(const GAS v4u*)(Z + (size_t)row * ZLD + (qn == 0 ? ZR : (qn == 1 ? ZKB : ZVB)) + c);
}
__device__ __forceinline__ void rwkv_prep_wave(const Args& a, int gw, int NGW, int lane) {
    const bf16* Z = (const bf16*)(a.ws + WS_Z);
    bf16* RK = (bf16*)(a.ws + WS_RKVK);
    const int c = (gw & 3) * 512 + 8 * lane;
    float cw[3][3][8], kkw[8];
#pragma unroll
    for (int qn = 0; qn < 3; ++qn)
#pragma unroll
        for (int tap = 0; tap < 3; ++tap)
#pragma unroll
            for (int h = 0; h < 2; ++h) { const af4 t = *(const GAS af4*)(a.in[I_CONV] + tap * 3 * BW + qn * BW + c + 4 * h);
#pragma unroll
                for (int e = 0; e < 4; ++e) cw[qn][tap][4 * h + e] = t[e]; }
#pragma unroll
    for (int h = 0; h < 2; ++h) { const af4 t = *(const GAS af4*)(a.in[I_KK] + c + 4 * h);
#pragma unroll
        for (int e = 0; e < 4; ++e) kkw[4 * h + e] = t[e]; }
    const int nq = NGW >> 2, wq = gw >> 2, per = (MALL + nq - 1) / nq;
    const int r0 = wq * per, r1 = (r0 + per < MALL) ? r0 + per : MALL;
    if (r0 >= r1) return;
    const v4u z4 = {0u, 0u, 0u, 0u};
    v4u P[3] = {z4, z4, z4}, C[3], N[3] = {z4, z4, z4}, N2[3] = {z4, z4, z4}, N3[3];
    if (r0 > 0) prep_load_row(Z, r0 - 1, c, P);
    prep_load_row(Z, r0, c, C);
    if (r0 + 1 < MALL) prep_load_row(Z, r0 + 1, c, N);
    if (r0 + 2 < MALL && r0 + 2 <= r1) prep_load_row(Z, r0 + 2, c, N2);
    for (int row = r0; row < r1; ++row) {
#pragma unroll
        for (int qn = 0; qn < 3; ++qn) N3[qn] = z4;
        if (row + 3 < MALL && row + 3 <= r1) prep_load_row(Z, row + 3, c, N3);
        bool hp, hn;
        if (row < MLAT) { const int t = row & (SEQ - 1); hp = t > 0; hn = t < SEQ - 1; } else { const int l = (row - MLAT) & (CTXL - 1); hp = l > 0; hn = l < CTXL - 1; }
        float outv[3][8];
#pragma unroll
        for (int qn = 0; qn < 3; ++qn) {
            float x0[8], x1[8], x2[8];
            unpack8(hp ? P[qn] : z4, x0); unpack8(C[qn], x1); unpack8(hn ? N[qn] : z4, x2);
#pragma unroll
            for (int e = 0; e < 8; ++e) outv[qn][e] = x0[e] * cw[qn][0][e] + x1[e] * cw[qn][1][e] + x2[e] * cw[qn][2][e];
        }
        float kk[8]; float ss = 0.f;
#pragma unroll
        for (int e = 0; e < 8; ++e) { kk[e] = outv[1][e] * kkw[e]; ss += kk[e] * kk[e]; }
        ss = sum8(ss);
        const float inv = 1.0f / fmaxf(sqrtf(ss), 1e-12f);
#pragma unroll
        for (int e = 0; e < 8; ++e) kk[e] *= inv;
        const size_t o = (size_t)row * BW + c, QS = (size_t)MALL * BW;
        *(GAS v4u*)(RK + o) = pack8(outv[0]); *(GAS v4u*)(RK + QS + o) = pack8(outv[1]); *(GAS v4u*)(RK + 2 * QS + o) = pack8(outv[2]); *(GAS v4u*)(RK + 3 * QS + o) = pack8(kk);
#pragma unroll
        for (int qn = 0; qn < 3; ++qn) { P[qn] = C[qn]; C[qn] = N[qn]; N[qn] = N2[qn]; N2[qn] = N3[qn]; }
    }
}

typedef short bf16x4 __attribute__((ext_vector_type(4)));
typedef __bf16 bf16v4_t __attribute__((ext_vector_type(4)));
typedef __bf16 bf16v2c_t __attribute__((ext_vector_type(2)));
__device__ __forceinline__ bf16x4 cvt4(const af4 x) {
    v2u w; w.x = __builtin_bit_cast(unsigned, __builtin_convertvector((f32x2){x[0], x[1]}, bf16v2c_t)); w.y = __builtin_bit_cast(unsigned, __builtin_convertvector((f32x2){x[2], x[3]}, bf16v2c_t));
    return __builtin_bit_cast(bf16x4, w); }
__device__ __forceinline__ bf16x4 lds4(const LAS unsigned char* p) { return __builtin_bit_cast(bf16x4, *(const LAS v2u*)p); }
#define MFMA16(a, b, c) __builtin_amdgcn_mfma_f32_16x16x16bf16_1k(a, b, c, 0, 0, 0)
constexpr int CRS = 144;
constexpr int CR_P = 0, CR_RT = 2304, CR_Q = 4608, CR_K = 6912, CR_V = 9216, CR_MKP = 11520, CR_MKR = 12032, CR_MQR = 12544, CR_TT = 13056, CR_G16 = 13568, CR_MF = 13824, CR_BYTES = 15360;
constexpr int CS_SCR = 8 * CR_BYTES, CS_SCR_BYTES = 16;
static_assert(CS_SCR + 4 * CS_SCR_BYTES + 64 <= LDSCTL_OFF, "chunked-scan LDS map");

struct ScanCtx { const bf16 *pE, *pA, *pKK, *pK, *pR, *pV; bf16* YS; const float* ka; int b, h, dir; };
__device__ __forceinline__ int cs_rowof(const ScanCtx& c, int s) { return s < CTXL ? (MLAT + c.b * CTXL + (c.dir ? (CTXL - 1 - s) : s)) : (c.b * SEQ + (c.dir ? (SEQ - 1 - (s - CTXL)) : (s - CTXL))); }
typedef __bf16 bf16v2_t __attribute__((ext_vector_type(2)));
__device__ __forceinline__ unsigned cvt2(float lo, float hi) { return __builtin_bit_cast(unsigned, __builtin_convertvector((f32x2){lo, hi}, bf16v2_t)); }
template <int N> __device__ __forceinline__ float dpp_shr(float x) { return __builtin_bit_cast(float, __builtin_amdgcn_update_dpp(0, __builtin_bit_cast(int, x), 0x110 + N, 0xF, 0xF, false)); }

struct PrepRaw { v4u e[2], a[2], kk[2], k[2], r[2], v[2]; };
__device__ __forceinline__ void cs_prep_load(const ScanCtx& c, int chunk, int lane, PrepRaw& R) {
    const int row = cs_rowof(c, 16 * chunk) + (lane & 15) * (c.dir ? -1 : 1);
    const size_t o = (size_t)row * BW + c.h * 64 + 16 * (lane >> 4);
#pragma unroll
    for (int i = 0; i < 2; ++i) { R.e[i] = *(const GAS v4u*)(c.pE + o + 8 * i); R.a[i] = *(const GAS v4u*)(c.pA + o + 8 * i); R.kk[i] = *(const GAS v4u*)(c.pKK + o + 8 * i);
        R.k[i] = *(const GAS v4u*)(c.pK + o + 8 * i); R.r[i] = *(const GAS v4u*)(c.pR + o + 8 * i); R.v[i] = *(const GAS v4u*)(c.pV + o + 8 * i); }
}
template <bool LOAD>
__device__ __forceinline__ void cs_prep_chunk(const ScanCtx& c, LAS unsigned char* rec, int next_chunk, int lane, const float (&kaw)[16], PrepRaw& R, PrepRaw& Rn) {
    if (LOAD) cs_prep_load(c, next_chunk, lane, Rn);
    const int t = lane & 15, kq = lane >> 4;
    const float t0 = (t == 0) ? 1.0f : 0.0f;
#pragma unroll
    for (int i = 0; i < 2; ++i) {
        float ef[8], af[8], kkf[8], kf[8], rf[8], gam[8], inv[8], gp[8];
        unpack8(R.e[i], ef); unpack8(R.a[i], af); unpack8(R.kk[i], kkf); unpack8(R.k[i], kf); unpack8(R.r[i], rf);
#pragma unroll
        for (int j = 0; j < 8; ++j) { float x = ef[j]; x += dpp_shr<1>(x); x += dpp_shr<2>(x); x += dpp_shr<4>(x); x += dpp_shr<8>(x);
            gam[j] = fexp2(-x); inv[j] = fexp2(x); gp[j] = dpp_shr<1>(gam[j]) + t0; }
        if (t == 15) { LAS float* gd = (LAS float*)(rec + CR_G16) + 16 * kq + 8 * i; *(LAS f32x4*)gd = (f32x4){gam[0], gam[1], gam[2], gam[3]}; *(LAS f32x4*)(gd + 4) = (f32x4){gam[4], gam[5], gam[6], gam[7]}; }
        float po[8], ro[8], qo[8], ko[8];
#pragma unroll
        for (int j = 0; j < 8; j += 2) {
            const f32x2 G = {gam[j], gam[j + 1]}, I = {inv[j], inv[j + 1]}, GP = {gp[j], gp[j + 1]}, KK = {kkf[j], kkf[j + 1]}, A = {af[j], af[j + 1]}, K = {kf[j], kf[j + 1]}, Rr = {rf[j], rf[j + 1]}, KA = {kaw[8 * i + j], kaw[8 * i + j + 1]};
            const f32x2 p = GP * KK, q = (KK * A) * (-I), k = (K * ((A - 1.0f) * KA + 1.0f)) * I, r = G * Rr;
            po[j] = p.x; po[j + 1] = p.y; qo[j] = q.x; qo[j + 1] = q.y; ko[j] = k.x; ko[j + 1] = k.y; ro[j] = r.x; ro[j + 1] = r.y;
        }
        const int off = t * CRS + (16 * kq + 8 * i) * 2;
        v4u w;
        w.x = cvt2(po[0], po[1]); w.y = cvt2(po[2], po[3]); w.z = cvt2(po[4], po[5]); w.w = cvt2(po[6], po[7]); *(LAS v4u*)(rec + CR_P + off) = w;
        w.x = cvt2(ro[0], ro[1]); w.y = cvt2(ro[2], ro[3]); w.z = cvt2(ro[4], ro[5]); w.w = cvt2(ro[6], ro[7]); *(LAS v4u*)(rec + CR_RT + off) = w;
        w.x = cvt2(qo[0], qo[1]); w.y = cvt2(qo[2], qo[3]); w.z = cvt2(qo[4], qo[5]); w.w = cvt2(qo[6], qo[7]); *(LAS v4u*)(rec + CR_Q + off) = w;
        w.x = cvt2(ko[0], ko[1]); w.y = cvt2(ko[2], ko[3]); w.z = cvt2(ko[4], ko[5]); w.w = cvt2(ko[6], ko[7]); *(LAS v4u*)(rec + CR_K + off) = w;
        *(LAS v4u*)(rec + CR_V + off) = R.v[i];
    }
    LDS_WAIT(); asm volatile("" ::: "memory");
    const int c16 = lane & 15, g = lane >> 4;
    af4 wt = {0.f, 0.f, 0.f, 0.f}, vt = wt, mkp = wt, mkr = wt, mqr = wt;
#pragma unroll
    for (int kt = 0; kt < 4; ++kt) {
        const int off = c16 * CRS + (16 * kt + 4 * g) * 2;
        const bf16x4 qa = lds4(rec + CR_Q + off), kaa = lds4(rec + CR_K + off), pb = lds4(rec + CR_P + off), rb = lds4(rec + CR_RT + off);
        wt = MFMA16(pb, qa, wt); vt = MFMA16(qa, pb, vt); mkp = MFMA16(kaa, pb, mkp); mkr = MFMA16(kaa, rb, mkr); mqr = MFMA16(qa, rb, mqr);
    }
#pragma unroll
    for (int r = 0; r < 4; ++r) { const int sI = 4 * g + r;
        if (!(c16 < sI)) wt[r] = 0.f;
        if (!(sI < c16)) { vt[r] = 0.f; mkp[r] = 0.f; }
        if (!(sI <= c16)) { mkr[r] = 0.f; mqr[r] = 0.f; } }
    *(LAS v2u*)(rec + CR_MKP + c16 * 32 + 8 * g) = __builtin_bit_cast(v2u, cvt4(mkp));
    *(LAS v2u*)(rec + CR_MKR + c16 * 32 + 8 * g) = __builtin_bit_cast(v2u, cvt4(mkr));
    *(LAS v2u*)(rec + CR_MQR + c16 * 32 + 8 * g) = __builtin_bit_cast(v2u, cvt4(mqr));
    const af4 z4 = {0.f, 0.f, 0.f, 0.f};
    const bf16x4 w1 = cvt4(wt), v1 = cvt4(vt);
    const af4 W2 = MFMA16(v1, w1, z4), V2 = MFMA16(w1, v1, z4);
    const bf16x4 w2 = cvt4(W2), v2 = cvt4(V2);
    const af4 W4 = MFMA16(v2, w2, z4), V4 = MFMA16(w2, v2, z4);
    const bf16x4 w4 = cvt4(W4), v4 = cvt4(V4);
    af4 pT = MFMA16(w4, v4, z4);
#pragma unroll
    for (int r = 0; r < 4; ++r) pT[r] += (4 * g + r == c16) ? 1.0f : 0.0f;
    pT = MFMA16(w4, cvt4(pT), pT);
    pT = MFMA16(w2, cvt4(pT), pT);
    pT = MFMA16(w1, cvt4(pT), pT);
    *(LAS v2u*)(rec + CR_TT + c16 * 32 + 8 * g) = __builtin_bit_cast(v2u, cvt4(pT));
    LDS_WAIT(); asm volatile("" ::: "memory");
}
__device__ __forceinline__ bf16x4 gath4(const LAS unsigned char* m, int g, int c16, int col0) {
    const LAS unsigned char* p = m + (4 * g + (c16 >> 2)) * CRS + (col0 + 4 * (c16 & 3)) * 2;
    return __builtin_amdgcn_ds_read_tr16_b64_v4i16((LAS bf16x4*)p);
}
struct SFrag { bf16x4 p[4], rt[4], kf[4], qf[4], vf, mkp, mkr, tt, mqr; f32x4 gm[4]; };
__device__ __forceinline__ void cs_state_load(const LAS unsigned char* rec, int w, int lane, SFrag& F) {
    const int c16 = lane & 15, g = lane >> 4;
#pragma unroll
    for (int kt = 0; kt < 4; ++kt) { const int off = c16 * CRS + (16 * kt + 4 * g) * 2; F.p[kt] = lds4(rec + CR_P + off); F.rt[kt] = lds4(rec + CR_RT + off); }
    F.vf = gath4(rec + CR_V, g, c16, 16 * w);
    F.mkp = lds4(rec + CR_MKP + c16 * 32 + 8 * g); F.mkr = lds4(rec + CR_MKR + c16 * 32 + 8 * g); F.tt = lds4(rec + CR_TT + c16 * 32 + 8 * g); F.mqr = lds4(rec + CR_MQR + c16 * 32 + 8 * g);
#pragma unroll
    for (int kt = 0; kt < 4; ++kt) { F.kf[kt] = gath4(rec + CR_K, g, c16, 16 * kt); F.qf[kt] = gath4(rec + CR_Q, g, c16, 16 * kt); F.gm[kt] = *(const LAS f32x4*)(rec + CR_G16 + (16 * kt + 4 * g) * 4); }
}
__device__ __forceinline__ void cs_state_compute(const ScanCtx& c, const SFrag& F, int w, int lane, af4 (&ST)[4], int chunk, bool store) {
    const int c16 = lane & 15, g = lane >> 4;
    bf16x4 sb[4];
#pragma unroll
    for (int kt = 0; kt < 4; ++kt) sb[kt] = cvt4(ST[kt]);
    af4 X = {0.f, 0.f, 0.f, 0.f}, Y = X;
#pragma unroll
    for (int kt = 0; kt < 4; ++kt) { X = MFMA16(F.p[kt], sb[kt], X); Y = MFMA16(F.rt[kt], sb[kt], Y); }
    X = MFMA16(F.mkp, F.vf, X);
    Y = MFMA16(F.mkr, F.vf, Y);
    const bf16x4 xb = cvt4(X);
    af4 U = {0.f, 0.f, 0.f, 0.f};
    U = MFMA16(F.tt, xb, U);
    const bf16x4 ub = cvt4(U);
    Y = MFMA16(F.mqr, ub, Y);
#pragma unroll
    for (int kt = 0; kt < 4; ++kt) {
        af4 sN = ST[kt];
        sN = MFMA16(F.kf[kt], F.vf, sN);
        sN = MFMA16(F.qf[kt], ub, sN);
        ST[kt] = sN * F.gm[kt];
    }
    if (store) {
        const int row0 = cs_rowof(c, 16 * chunk), rst = c.dir ? -1 : 1;
        bf16* yb = c.YS + (size_t)row0 * BW + c.h * 64 + 16 * w;
        const unsigned y01 = cvt2(Y[0], Y[1]), y23 = cvt2(Y[2], Y[3]);
        const int ro = (4 * g) * rst * BW + c16;
        yb[ro] = (bf16)(y01 & 0xffffu); yb[ro + rst * BW] = (bf16)(y01 >> 16); yb[ro + 2 * rst * BW] = (bf16)(y23 & 0xffffu); yb[ro + 3 * rst * BW] = (bf16)(y23 >> 16);
    }
}

__device__ __forceinline__ void scan_chunked(const Args& a, LAS unsigned char* lds, int sid, int tid) {
    ScanCtx c; c.dir = sid & 1; c.h = (sid >> 1) & 31; c.b = sid >> 6;
    const bf16* RK = (const bf16*)(a.ws + WS_RKVK); const bf16* EK = (const bf16*)(a.ws + WS_EKK); const size_t QS = (size_t)MALL * BW;
    c.pKK = RK + 3 * QS; c.pE = EK + (size_t)c.dir * QS; c.pA = EK + (size_t)(2 + c.dir) * QS; c.pK = RK + QS; c.pR = RK; c.pV = RK + 2 * QS;
    c.YS = (bf16*)(a.ws + WS_YS) + (size_t)c.dir * MLAT * BW; c.ka = a.in[I_KA];
    const int wave = __builtin_amdgcn_readfirstlane(tid >> 6), lane = tid & 63;
    constexpr int NG = (CTXL + SEQ) / 64;
    static_assert(NG % 2 == 0, "the group loop is unrolled by two");
#define CS_BAR() do { asm volatile("s_waitcnt lgkmcnt(0)" ::: "memory"); __builtin_amdgcn_s_barrier(); asm volatile("" ::: "memory"); } while (0)
    if (wave >= 4) {
        PrepRaw RA, RB; float kaw[16];
#pragma unroll
        for (int j = 0; j < 16; ++j) kaw[j] = c.ka[c.h * 64 + 16 * (lane >> 4) + j];
        const int pw = wave - 4;
        cs_prep_load(c, pw, lane, RA); cs_prep_chunk<true>(c, lds + pw * CR_BYTES, 4 + pw, lane, kaw, RA, RB);
        CS_BAR();
        for (int gi = 0; gi < NG - 2; gi += 2) {
            cs_prep_chunk<true>(c, lds + (4 + pw) * CR_BYTES, 4 * (gi + 2) + pw, lane, kaw, RB, RA);
            CS_BAR();
            cs_prep_chunk<true>(c, lds + pw * CR_BYTES, 4 * (gi + 3) + pw, lane, kaw, RA, RB);
            CS_BAR();
        }
        cs_prep_chunk<false>(c, lds + (4 + pw) * CR_BYTES, 0, lane, kaw, RB, RA);
        CS_BAR();
        CS_BAR();
    } else {
        af4 ST[4];
#pragma unroll
        for (int kt = 0; kt < 4; ++kt) ST[kt] = (af4){0.f, 0.f, 0.f, 0.f};
        CS_BAR();
        for (int gi = 0; gi < NG; ++gi) {
            const LAS unsigned char* rg = lds + (gi & 1) * 4 * CR_BYTES; const bool st = gi >= CTXL / 64;
            SFrag F0, F1;
            cs_state_load(rg, wave, lane, F0);
            cs_state_load(rg + CR_BYTES, wave, lane, F1);     cs_state_compute(c, F0, wave, lane, ST, 4 * gi, st);
            cs_state_load(rg + 2 * CR_BYTES, wave, lane, F0); cs_state_compute(c, F1, wave, lane, ST, 4 * gi + 1, st);
            cs_state_load(rg + 3 * CR_BYTES, wave, lane, F1); cs_state_compute(c, F0, wave, lane, ST, 4 * gi + 2, st);
            cs_state_compute(c, F1, wave, lane, ST, 4 * gi + 3, st);
            CS_BAR();
        }
    }
#undef CS_BAR
}

struct RoIn { v4u y0, y1, r, k, v, g; };
__device__ __forceinline__ void ro_load(const Args& a, int row, int c, RoIn& in) {
    const bf16* Z = (const bf16*)(a.ws + WS_Z); const bf16* RK = (const bf16*)(a.ws + WS_RKVK); const bf16* YS = (const bf16*)(a.ws + WS_YS);
    const size_t o = (size_t)row * BW + c, QS = (size_t)MALL * BW;
    in.y0 = *(const GAS v4u*)(YS + o); in.y1 = *(const GAS v4u*)(YS + (size_t)MLAT * BW + o);
    in.r = *(const GAS v4u*)(RK + o); in.k = *(const GAS v4u*)(RK + QS + o); in.v = *(const GAS v4u*)(RK + 2 * QS + o);
    in.g = *(const GAS v4u*)(Z + (size_t)row * ZLD + ZGB + c);
}
__device__ __forceinline__ void readout_wave(const Args& a, int gw, int NGW, int lane) {
    bf16* OAB = (bf16*)(a.ws + WS_OAB);
    const int c = (gw & 3) * 512 + 8 * lane;
    float rk[8], gw_[8], gbias[8];
#pragma unroll
    for (int h = 0; h < 2; ++h) { const af4 t0 = *(const GAS af4*)(a.in[I_RK] + c + 4 * h), t1 = *(const GAS af4*)(a.in[I_GNW] + c + 4 * h), t2 = *(const GAS af4*)(a.in[I_GNB] + c + 4 * h);
#pragma unroll
        for (int e = 0; e < 4; ++e) { rk[4 * h + e] = t0[e]; gw_[4 * h + e] = t1[e]; gbias[4 * h + e] = t2[e]; } }
    RoIn cur, nxt;
    int item = gw;
    if (item < MLAT * 4) ro_load(a, item >> 2, c, cur);
    while (item < MLAT * 4) {
        const int nitem = item + NGW;
        if (nitem < MLAT * 4) ro_load(a, nitem >> 2, c, nxt);
        const int row = item >> 2;
        float y0[8], y1[8], r[8], k[8], vv[8], gb[8];
        unpack8(cur.y0, y0); unpack8(cur.y1, y1); unpack8(cur.r, r); unpack8(cur.k, k); unpack8(cur.v, vv); unpack8(cur.g, gb);
        float s = 0.f, bon = 0.f;
#pragma unroll
        for (int e = 0; e < 8; ++e) { y0[e] += y1[e]; s += y0[e]; bon += r[e] * k[e] * rk[e]; }
        s = sum8(s); bon = sum8(bon);
        const float mean = s * (1.0f / 64.0f); float q = 0.f;
#pragma unroll
        for (int e = 0; e < 8; ++e) { y0[e] -= mean; q += y0[e] * y0[e]; }
        q = sum8(q);
        const float rstd = 1.0f / sqrtf(q * (1.0f / 64.0f) + 64e-5f);
        float outv[8];
#pragma unroll
        for (int e = 0; e < 8; ++e) outv[e] = (y0[e] * rstd * gw_[e] + gbias[e] + bon * vv[e]) * siluf_(gb[e]);
        *(GAS v4u*)(OAB + (size_t)row * D + BW + c) = pack8(outv);
        cur = nxt; item = nitem;
    }
}

__global__ void __launch_bounds__(NTHREADS, 2) fwd(Args a) {
    extern __shared__ __attribute__((aligned(16))) unsigned char lds_raw[];
    LAS unsigned char* lds = (LAS unsigned char*)lds_raw;
    const int G = gridDim.x, bx = blockIdx.x;
    unsigned char* ws = a.ws;
    volatile LAS unsigned* MISC = (volatile LAS unsigned*)(lds + LDSCTL_OFF);
    if (threadIdx.x < 64) MISC[threadIdx.x] = 0u;
    __syncthreads();
    XcdBarrier bar; bar.bar = (unsigned*)(ws + WS_CTL) + CW_BAR; bar.x = 0; bar.st = nullptr;
    if (MK_N_LAUNCHES == 1) bar = xcd_barrier_post((unsigned*)(ws + WS_CTL) + CW_BAR, MISC + 8);
    const int lo = a.ph_lo, hi = a.ph_hi;
#ifdef ONLY_PHASE
#define IN(k) ((k) == ONLY_PHASE)
#else
#define IN(k) (lo <= (k) && (k) < hi)
#endif
#define REPS(k) _Pragma("unroll") for (int _rep = 0; _rep < ((k) == REP_PHASE ? REP_COUNT : 1); ++_rep)
#define SEAM(k) do { if (IN(k) && IN((k) + 1)) xcd_barrier(bar); } while (0)
    const int NGW = G * NWAVES;
    float* modv = (float*)(ws + WS_MODV);

    REPS(0) { if (_rep) xcd_barrier(bar);
    if (IN(0)) { p0_phase(a, lds); }
    }
    SEAM(0);
    REPS(1) { if (_rep) xcd_barrier(bar);
    if (IN(1)) { norm_phase(a, lds, 0, a.in[I_X], a.in[I_CTX], MALL, nullptr, nullptr); }
    }
    SEAM(1);
    REPS(2) { if (_rep) xcd_barrier(bar);
    if (IN(2)) {
        pg8::Gemm g{(const bf16*)(ws + WS_H), (const bf16*)(ws + WS_WIN0), MALL, ZLD, D, D}; pg8::StaticOrder S; S.init(MALL, ZLD, G, bx);
        EpiZ E{(bf16*)(ws + WS_Z), (bf16*)(ws + WS_VTA), (const float*)(ws + WS_ROPE)};
        pg8::gemm_phase<EpiZ, pg8::StaticOrder, true, true>(lds, g, S, E);
    }
    }
#ifdef PROBE_NULL_G1
    { xcd_barrier(bar);
        pg8::Gemm g{(const bf16*)(ws + WS_H), (const bf16*)(ws + WS_WIN0), MALL, ZLD, D, D}; pg8::StaticOrder S; S.init(MALL, ZLD, G, bx);
        EpiNull E{};
        pg8::gemm_phase<EpiNull, pg8::StaticOrder, true, true>(lds, g, S, E); }
#endif
    SEAM(2);
    REPS(3) { if (_rep) xcd_barrier(bar);
    if (IN(3)) {
        const int tid = my_tid(), lane = tid & 63, wave = __builtin_amdgcn_readfirstlane(tid >> 6), gw = bx * NWAVES + wave;
        rwkv_prep_wave(a, gw, NGW, lane);
        for (int u = ATT_P5 + bx; u < 1024; u += G) attn_unit(a, lds, u, tid, lane, wave);
    }
    }
    REPS(4) { if (_rep) xcd_barrier(bar);
    if (IN(4)) {
        int Kl = 128; asm volatile("" : "+s"(Kl));
        pg8::Gemm g{(const bf16*)(ws + WS_Z) + ZDL, (const bf16*)(ws + WS_WLORA), MALL, 8192, Kl, ZLD, 3, 256}; pg8::StaticOrder S; S.init(MALL, 8192, G, bx);
        EpiLora E{a.in[I_W0], a.in[I_A0], (bf16*)(ws + WS_EKK)};
        pg8::gemm_phase<EpiLora, pg8::StaticOrder, true, true>(lds, g, S, E);
    }
    }
    SEAM(4);
    REPS(5) { if (_rep) xcd_barrier(bar);
    if (IN(5)) {
        const int tid = my_tid(), lane = tid & 63, wave = __builtin_amdgcn_readfirstlane(tid >> 6);
        const int nsb = G >= 256 ? 128 : G;
        if (bx < nsb) for (int sid = bx; sid < 128; sid += nsb) scan_chunked(a, lds, sid, tid);
        const int tb = G >= 256 ? bx - 128 : bx, ntb = G >= 256 ? G - 128 : G;
        if (tb >= 0) {
            LAS float* scr = (LAS float*)(lds + wave * 16384);
            float x[32], xn[32];
            for (int u = tb; u < ATT_P5; u += ntb) attn_unit(a, lds, u, tid, lane, wave);
            static_assert(L1_P5 <= TR_I2, "the phase-5 items are all gm_w_in items");
            const int jst = ntb * NWAVES; int j = tb * NWAVES + wave;
            auto ldi = [&](int jj, float (&xx)[32]) { tr_load_nc(a.in[I_GWIN], 3 * CW, 2, jj < L1_P5 ? jj : L1_P5 - 1, lane, TR_NB2, xx); };
            auto sti = [&](int jj, const float (&xx)[32]) { tr_store((bf16*)(a.ws + WS_WGIN), D, scr, jj, lane, TR_NB2, xx); };
            float xc[32];
            ldi(j, x); ldi(j + jst, xn);
            while (j + 2 * jst < L1_P5) {
                ldi(j + 2 * jst, xc); sti(j, x);
                ldi(j + 3 * jst, x);  sti(j + jst, xn);
                ldi(j + 4 * jst, xn); sti(j + 2 * jst, xc);
                j += 3 * jst;
            }
            if (j < L1_P5) sti(j, x);
            if (j + jst < L1_P5) sti(j + jst, xn);
        }
    }
    }
    SEAM(5);
    REPS(6) { if (_rep) xcd_barrier(bar);
    if (IN(6)) { const int tid = my_tid(), lane = tid & 63, gw = bx * NWAVES + __builtin_amdgcn_readfirstlane(tid >> 6); readout_wave(a, gw, NGW, lane); }
    }
    SEAM(6);
    REPS(7) { if (_rep) xcd_barrier(bar);
    if (IN(7)) {
        pg8::Gemm g{(const bf16*)(ws + WS_OAB), (const bf16*)(ws + WS_WOUT0), MLAT, D, D, D}; pg8::StaticOrder S; S.init(MLAT, D, G, bx);
        EpiGateOut E{(bf16*)(ws + WS_Y0), modv + 2 * D};
        pg8::gemm_phase<EpiGateOut, pg8::StaticOrder, true, true>(lds, g, S, E);
    }
    }
    SEAM(7);
    REPS(8) { if (_rep) xcd_barrier(bar);
    if (IN(8)) { norm_phase(a, lds, 1, a.in[I_X], nullptr, MLAT, (const bf16*)(ws + WS_Y0), (bf16*)(ws + WS_X1)); }
    }
    SEAM(8);
    REPS(9) { if (_rep) xcd_barrier(bar);
    if (IN(9)) {
        pg8::Gemm g{(const bf16*)(ws + WS_WGIN), (const bf16*)(ws + WS_H), CW, MLAT, D, D}; pg8::StaticOrder S; S.init(CW, MLAT, G, bx);
        EpiVT E{(bf16*)(ws + WS_VT), (float*)(ws + WS_STATP)};
        pg8::gemm_phase<EpiVT, pg8::StaticOrder, true, true>(lds, g, S, E);
    }
    }
    SEAM(9);
    REPS(10) { if (_rep) xcd_barrier(bar);
    if (IN(10)) {
        const int tid = my_tid(), lane = tid & 63, gw = bx * NWAVES + __builtin_amdgcn_readfirstlane(tid >> 6);
        const float* sp = (const float*)(ws + WS_STATP); float* st = (float*)(ws + WS_STATS);
        for (int row = gw; row < MLAT; row += NGW) {
            float s1 = 0.f, s2 = 0.f;
            { const f32x2 p = *(const GAS f32x2*)(sp + ((size_t)row * 96 + lane) * 2); s1 = p.x; s2 = p.y; }
            if (lane < 32) { const f32x2 p = *(const GAS f32x2*)(sp + ((size_t)row * 96 + 64 + lane) * 2); s1 += p.x; s2 += p.y; }
            s1 = wave_sum(s1); s2 = wave_sum(s2);
            const float mean = s1 * (1.0f / CW), var = fmaxf(s2 * (1.0f / CW) - mean * mean, 0.f);
            const float rstd = 1.0f / sqrtf(var + 1e-5f);
            if (lane == 0) { float* sq = st + (size_t)(row >> 1) * 4 + (row & 1); sq[0] = -mean * rstd; sq[2] = rstd; }
        }
    }
    }
    SEAM(10);
    REPS(11) { if (_rep) xcd_barrier(bar);
    if (IN(11)) {
        pg8::Gemm g{(const bf16*)(ws + WS_H), (const bf16*)(ws + WS_WGIN) + (size_t)CW * D, MLAT, 2 * CW, D, D}; pg8::StaticOrder S; S.init(MLAT, 2 * CW, G, bx);
        EpiGate E{(const bf16*)(ws + WS_VT), (const float*)(ws + WS_STATS), (const bf16*)(ws + WS_WSB), a.in[I_BS], a.in[I_LNG], a.in[I_LNB], (bf16*)(ws + WS_Y)};
        pg8::gemm_phase<EpiGate, pg8::StaticOrder, true, true>(lds, g, S, E);
    }
    }
    SEAM(11);
    REPS(12) { if (_rep) xcd_barrier(bar);
    if (IN(12)) {
        pg8::Gemm g{(const bf16*)(ws + WS_Y), (const bf16*)(ws + WS_WGOUT), MLAT, D, CW, CW}; pg8::StaticOrder S; S.init(MLAT, D, G, bx);
        EpiGateOut E{(bf16*)(ws + WS_Y1), modv + 3 * 3 * D + 2 * D};
        pg8::gemm_phase<EpiGateOut, pg8::StaticOrder, true, true>(lds, g, S, E);
    }
    }
    SEAM(12);
    if (IN(13)) {
        const int tid = my_tid(), lane = tid & 63, gw = bx * NWAVES + __builtin_amdgcn_readfirstlane(tid >> 6);
        const float* fg = a.in[I_FING]; const bf16* X1 = (const bf16*)(ws + WS_X1); const bf16* Y1 = (const bf16*)(ws + WS_Y1);
        f32x4 v[16]; v2u xv[16], xn[16], yv[16], yn[16];
        auto loadrow = [&](int row, v2u (&dst)[16], v2u (&yd)[16]) {
            const GAS v2u* xp = (const GAS v2u*)(X1 + (size_t)row * D) + lane; const GAS v2u* yp = (const GAS v2u*)(Y1 + (size_t)row * D) + lane;
#pragma unroll
            for (int q = 0; q < 16; ++q) { dst[q] = xp[64 * q]; yd[q] = yp[64 * q]; }
        };
        int row = gw;
        if (row < MLAT) loadrow(row, xv, yv);
        while (row < MLAT) {
            const int nrow = row + NGW;
            if (nrow < MLAT) loadrow(nrow, xn, yn);
            GAS f32x4* op = (GAS f32x4*)(a.out + (size_t)row * D) + lane;
            float s = 0.f;
#pragma unroll
            for (int q = 0; q < 16; ++q) { v[q] = (f32x4){bflo(xv[q].x), bfhi(xv[q].x), bflo(xv[q].y), bfhi(xv[q].y)} + (f32x4){bflo(yv[q].x), bfhi(yv[q].x), bflo(yv[q].y), bfhi(yv[q].y)}; s += (v[q].x * v[q].x + v[q].y * v[q].y) + (v[q].z * v[q].z + v[q].w * v[q].w); }
            const float rstd = 1.0f / sqrtf(wave_sum(s) * (1.0f / D) + 1e-6f);
#pragma unroll
            for (int q = 0; q < 16; ++q) { const f32x4 gg = *(const GAS f32x4*)(fg + 4 * lane + 256 * q); op[64 * q] = v[q] * rstd * gg; }
#pragma unroll
            for (int q = 0; q < 16; ++q) { xv[q] = xn[q]; yv[q] = yn[q]; }
            row = nrow;
        }
    }
#undef IN
#undef SEAM
}

extern "C" void kernel_launch(void* const* d_in, const int* in_sizes, int n_in, void* d_out, int out_size, void* d_ws, size_t ws_size, hipStream_t stream) {
    static int grid = 0;
    if (grid == 0) {
        if (n_in != 27 || in_sizes[0] != MLAT * D || out_size != MLAT * D || ws_size < WS_END) { fprintf(stderr, "kernel_launch: unexpected shapes (n_in %d, ws %zu < %zu?)\n", n_in, ws_size, (size_t)WS_END); grid = -1; return; }
        int dev = 0, cus = 0, per_cu = 0;
        if (hipGetDevice(&dev) != hipSuccess || hipDeviceGetAttribute(&cus, hipDeviceAttributeMultiprocessorCount, dev) != hipSuccess) { grid = -1; return; }
        if (hipFuncSetAttribute((const void*)fwd, hipFuncAttributeMaxDynamicSharedMemorySize, LDS_BYTES) != hipSuccess) { fprintf(stderr, "kernel_launch: hipFuncSetAttribute failed\n"); grid = -1; return; }
        if (hipOccupancyMaxActiveBlocksPerMultiprocessor(&per_cu, (const void*)fwd, NTHREADS, LDS_BYTES) != hipSuccess || per_cu < 1) { fprintf(stderr, "kernel_launch: occupancy query says %d\n", per_cu); }
        (void)hipGetLastError();
        grid = cus;
    }
    if (grid < 0) return;
    if (hipMemsetAsync((char*)d_ws + WS_CTL, 0, CTL_ZERO_BYTES, stream) != hipSuccess) return;
    Args a{};
    for (int i = 0; i < 27; ++i) a.in[i] = (const float*)d_in[i];
    a.out = (float*)d_out; a.ws = (unsigned char*)d_ws;
    if (MK_N_LAUNCHES == 1) { a.ph_lo = 0; a.ph_hi = NPHASE; hipLaunchKernelGGL(fwd, dim3(grid), dim3(NTHREADS), LDS_BYTES, stream, a); }
    else for (int p = 0; p < NPHASE; ++p) { a.ph_lo = p; a.ph_hi = p + 1; hipLaunchKernelGGL(fwd, dim3(grid), dim3(NTHREADS), LDS_BYTES, stream, a); }
}
```

```cpp
#include <hip/hip_runtime.h>
#include <cstdio>
#include <cstdint>

#define REP_PHASE -1
#define REP_COUNT 2
#ifndef MK_N_LAUNCHES
#define MK_N_LAUNCHES 1
#endif

namespace pg8 {
#define PG8_LAS __attribute__((address_space(3)))
typedef unsigned short bf16_t;
typedef short bf16x8 __attribute__((ext_vector_type(8)));
typedef float f32x4 __attribute__((ext_vector_type(4)));
typedef unsigned u32x4 __attribute__((ext_vector_type(4)));
constexpr int BM = 256, BK = 64, HALF = 128, HTB = HALF * BK * 2, STAGE_BYTES = 8 * HTB, NXCD = 8, WGM = 8;

__host__ __device__ __forceinline__ int lds_byte(int r, int c) { const int st = (r >> 4) * 2 + (c >> 5), rr = r & 15, cc = c & 31, ob = rr * 64 + cc * 2; return st * 1024 + (ob ^ (((ob >> 9) & 1) << 5)); }
__host__ __device__ __forceinline__ void stage_rc(int b, int& R, int& C) { const int st = b / 1024, sb = b % 1024, swz = sb ^ (((sb >> 9) & 1) << 5); R = (st >> 1) * 16 + swz / 64; C = (st & 1) * 32 + (swz % 64) / 2; }
__host__ __device__ __forceinline__ int perm32(int rho) { const int n = rho >> 4, i = rho & 15; return 8 * (i >> 2) + 4 * n + (i & 3); }

struct Unit { int pm, pn; };
struct Gemm { const bf16_t* A; const bf16_t* Bt; int M, N, K, lda; int a_shift = 0, a_stride = 0; };

struct StaticOrder {
    int nM, nN, nwg, G, c;
    __host__ __device__ void init(int M, int N, int G_, int c_) { nM = M / BM; nN = N / BM; nwg = nM * nN; G = G_; c = c_; }
    __host__ __device__ bool next(int i, Unit& u) const {
        const long L = (long)i * G + c; if (L >= nwg) return false;
        int wgid = (int)L; { const int q = nwg / NXCD, r = nwg % NXCD, xcd = wgid % NXCD, off = wgid / NXCD; wgid = (xcd < r ? xcd * (q + 1) : r * (q + 1) + (xcd - r) * q) + off; }
        const int nig = WGM * nN, gid = wgid / nig, fm = gid * WGM, gsz = (nM - fm) < WGM ? (nM - fm) : WGM;
        u.pm = fm + ((wgid % nig) % gsz); u.pn = (wgid % nig) / gsz; return true;
    }
    __device__ __forceinline__ void a_ready(const Unit&) const {}
    __device__ __forceinline__ void done(const Unit&) const {}
};

__device__ __forceinline__ unsigned cvt_pk_bf16(float lo, float hi) { unsigned r; asm volatile("v_cvt_pk_bf16_f32 %0, %1, %2" : "=v"(r) : "v"(lo), "v"(hi)); return r; }

template <class Epi, class Sched, bool ALIGN_EPI = false, bool SP2 = false>
__device__ __forceinline__ void gemm_phase(PG8_LAS unsigned char* lds, const Gemm g, const Sched& S, const Epi& E) {
    int tid = threadIdx.x; asm volatile("" : "+v"(tid)); const int wid = __builtin_amdgcn_readfirstlane(tid >> 6), lane = tid & 63, wr = wid >> 2, wc = wid & 3, fr = lane & 15, fq = lane >> 4;
    const int K = g.K, nt = K / BK, lda = g.lda;
    unsigned voffA[2], voffB[2];
#pragma unroll
    for (int i = 0; i < 2; ++i) { int R, C; stage_rc(tid * 16 + i * 8192, R, C); const int Rb = Epi::PERM ? ((R & ~31) + perm32(R & 31)) : R;
        voffA[i] = (unsigned)(R * lda + C) * 2u; voffB[i] = (unsigned)(Rb * K + C) * 2u; }
    const size_t kstep = (size_t)(BK * 2);
    const size_t hstepA = (size_t)HALF * lda * 2, hstepB = (size_t)HALF * K * 2;
    const size_t tstepA = 2 * hstepA, tstepB = 2 * hstepB;
    const unsigned ldsw = (unsigned)wid * 1024u;
    const int aoff = lds_byte(wr * 64 + fr, fq * 8), boff = lds_byte(wc * 32 + fr, fq * 8);
#define PG8_SA(b, h) (((b) * 2 + (h)) * HTB)
#define PG8_SB(b, h) ((4 + (b) * 2 + (h)) * HTB)
#define PG8_STAGE(bufoff, gbase, voff) do { _Pragma("unroll") for (int _i = 0; _i < 2; ++_i) \
        __builtin_amdgcn_global_load_lds((const unsigned*)((const char*)(gbase) + (voff)[_i]), (PG8_LAS unsigned*)(lds + (bufoff) + ldsw + _i * 8192), 16, 0, 0); } while (0)
#define PG8_LDA(dst, b, h) do { _Pragma("unroll") for (int m = 0; m < 4; ++m) _Pragma("unroll") for (int k = 0; k < 2; ++k) dst[m][k] = *(const PG8_LAS bf16x8*)(lds + PG8_SA(b, h) + aoff + m * 2048 + k * 1024); } while (0)
#define PG8_LDB(dst, b, h) do { _Pragma("unroll") for (int n = 0; n < 2; ++n) _Pragma("unroll") for (int k = 0; k < 2; ++k) dst[n][k] = *(const PG8_LAS bf16x8*)(lds + PG8_SB(b, h) + boff + n * 2048 + k * 1024); } while (0)
#define PG8_MMA(ai, bj, At, Bt) do { __builtin_amdgcn_s_setprio(1); _Pragma("unroll") for (int m = 0; m < 4; ++m) _Pragma("unroll") for (int n = 0; n < 2; ++n) _Pragma("unroll") for (int k = 0; k < 2; ++k) \
        acc[ai][bj][m][n] = __builtin_amdgcn_mfma_f32_16x16x32_bf16(Bt[n][k], At[m][k], acc[ai][bj][m][n], 0, 0, 0); __builtin_amdgcn_s_setprio(0); } while (0)
#define PG8_WAIT_V(n) asm volatile("s_waitcnt vmcnt(" #n ")" ::: "memory")
#define PG8_WAIT_L(n) asm volatile("s_waitcnt lgkmcnt(" #n ")" ::: "memory")
#define PG8_BAR __builtin_amdgcn_s_barrier()
#define PG8_SCHED __builtin_amdgcn_sched_barrier(0)
    Unit cur, nxt; int ui = 0;
    if (!S.next(0, cur)) return;
    f32x4 acc[2][2][4][2];
#pragma unroll
    for (int a = 0; a < 2; ++a)
#pragma unroll
        for (int b = 0; b < 2; ++b)
#pragma unroll
            for (int m = 0; m < 4; ++m)
#pragma unroll
                for (int n = 0; n < 2; ++n) acc[a][b][m][n] = (f32x4){0.f, 0.f, 0.f, 0.f};
    bf16x8 At[4][2], B0[2][2], B1[2][2];
    const char* cA = (const char*)g.A + (size_t)cur.pm * tstepA + (size_t)((cur.pn >> g.a_shift) * g.a_stride); const char* cB = (const char*)g.Bt + (size_t)cur.pn * tstepB;
    S.a_ready(cur);
    if constexpr (SP2) {
        PG8_STAGE(PG8_SB(0, 0), cB, voffB); PG8_STAGE(PG8_SB(0, 1), cB + hstepB, voffB); PG8_STAGE(PG8_SA(0, 0), cA, voffA); PG8_STAGE(PG8_SA(0, 1), cA + hstepA, voffA);
        if (wr == 1) PG8_BAR;
        PG8_WAIT_V(2); PG8_BAR;
        PG8_STAGE(PG8_SB(1, 0), cB + kstep, voffB); PG8_STAGE(PG8_SA(1, 0), cA + kstep, voffA); PG8_STAGE(PG8_SB(1, 1), cB + hstepB + kstep, voffB);
        PG8_WAIT_V(6); PG8_BAR;
    } else {
        PG8_STAGE(PG8_SB(0, 0), cB, voffB); PG8_STAGE(PG8_SA(0, 0), cA, voffA); PG8_STAGE(PG8_SB(0, 1), cB + hstepB, voffB); PG8_STAGE(PG8_SA(0, 1), cA + hstepA, voffA);
        if (wr == 1) PG8_BAR;
        PG8_WAIT_V(4); PG8_BAR;
        PG8_STAGE(PG8_SB(1, 0), cB + kstep, voffB); PG8_STAGE(PG8_SA(1, 0), cA + kstep, voffA); PG8_STAGE(PG8_SB(1, 1), cB + hstepB + kstep, voffB);
        PG8_WAIT_V(6); PG8_BAR;
    }
    for (;;) {
        const bool has_next = S.next(ui + 1, nxt);
        const char* nA = has_next ? (const char*)g.A + (size_t)nxt.pm * tstepA + (size_t)((nxt.pn >> g.a_shift) * g.a_stride) : cA; const char* nB = has_next ? (const char*)g.Bt + (size_t)nxt.pn * tstepB : cB;
#pragma clang loop unroll(disable)
        for (int t = 0; t < nt; t += 2) {
            const bool last = (t == nt - 2);
            const char* a1 = cA + (size_t)(t + 1) * kstep;
            const char* a2 = last ? nA : cA + (size_t)(t + 2) * kstep; const char* b2 = last ? nB : cB + (size_t)(t + 2) * kstep;
            const char* a3 = a2 + kstep; const char* b3 = b2 + kstep;
            if (last && has_next) S.a_ready(nxt);
            if constexpr (SP2) {
            PG8_LDB(B0, 0, 0); PG8_LDB(B1, 0, 1); PG8_SCHED; PG8_LDA(At, 0, 0); PG8_STAGE(PG8_SA(1, 1), a1 + hstepA, voffA);
            PG8_WAIT_V(8); PG8_WAIT_L(0); PG8_BAR; PG8_MMA(0, 0, At, B0); PG8_MMA(0, 1, At, B1); PG8_BAR; PG8_SCHED;
            PG8_LDA(At, 0, 1); PG8_STAGE(PG8_SB(0, 0), b2, voffB); PG8_STAGE(PG8_SB(0, 1), b2 + hstepB, voffB); PG8_STAGE(PG8_SA(0, 0), a2, voffA);
            PG8_WAIT_V(8); PG8_WAIT_L(0); PG8_BAR; PG8_MMA(1, 0, At, B0); PG8_MMA(1, 1, At, B1); PG8_BAR; PG8_SCHED;
            PG8_LDB(B0, 1, 0); PG8_LDB(B1, 1, 1); PG8_SCHED; PG8_LDA(At, 1, 0); PG8_STAGE(PG8_SA(0, 1), a2 + hstepA, voffA);
            PG8_WAIT_V(8); PG8_WAIT_L(0); PG8_BAR; PG8_MMA(0, 0, At, B0); PG8_MMA(0, 1, At, B1); PG8_BAR; PG8_SCHED;
            PG8_LDA(At, 1, 1); PG8_STAGE(PG8_SB(1, 0), b3, voffB); PG8_STAGE(PG8_SB(1, 1), b3 + hstepB, voffB); PG8_STAGE(PG8_SA(1, 0), a3, voffA);
            PG8_WAIT_V(8); PG8_WAIT_L(0); PG8_BAR; PG8_MMA(1, 0, At, B0); PG8_MMA(1, 1, At, B1); PG8_BAR; PG8_SCHED;
            } else {
            PG8_LDB(B0, 0, 0); PG8_SCHED; PG8_LDA(At, 0, 0); PG8_STAGE(PG8_SA(1, 1), a1 + hstepA, voffA);
            PG8_WAIT_L(8); PG8_BAR; PG8_WAIT_L(0); PG8_MMA(0, 0, At, B0); PG8_BAR; PG8_SCHED;
            PG8_LDB(B1, 0, 1); PG8_STAGE(PG8_SB(0, 0), b2, voffB);
            PG8_BAR; PG8_WAIT_L(0); PG8_MMA(0, 1, At, B1); PG8_BAR;
            PG8_LDA(At, 0, 1); PG8_STAGE(PG8_SA(0, 0), a2, voffA);
            PG8_BAR; PG8_WAIT_L(0); PG8_MMA(1, 0, At, B0); PG8_BAR; PG8_SCHED;
            PG8_STAGE(PG8_SB(0, 1), b2 + hstepB, voffB);
            PG8_WAIT_V(6); PG8_BAR; PG8_MMA(1, 1, At, B1); PG8_BAR;
            PG8_LDB(B0, 1, 0); PG8_SCHED; PG8_LDA(At, 1, 0); PG8_STAGE(PG8_SA(0, 1), a2 + hstepA, voffA);
            PG8_WAIT_L(8); PG8_BAR; PG8_WAIT_L(0); PG8_MMA(0, 0, At, B0); PG8_BAR; PG8_SCHED;
            PG8_LDB(B1, 1, 1); PG8_STAGE(PG8_SB(1, 0), b3, voffB);
            PG8_BAR; PG8_WAIT_L(0); PG8_MMA(0, 1, At, B1); PG8_BAR;
            PG8_LDA(At, 1, 1); PG8_STAGE(PG8_SA(1, 0), a3, voffA);
            PG8_BAR; PG8_WAIT_L(0); PG8_MMA(1, 0, At, B0); PG8_BAR; PG8_SCHED;
            PG8_STAGE(PG8_SB(1, 1), b3 + hstepB, voffB);
            PG8_WAIT_V(6); PG8_BAR; PG8_MMA(1, 1, At, B1); PG8_BAR;
            }
        }
        if constexpr (ALIGN_EPI) { if (wr == 0) PG8_BAR; }
        E(acc, cur, wr, wc, fr, fq);
        if (!has_next) break;
#pragma unroll
        for (int a = 0; a < 2; ++a)
#pragma unroll
            for (int b = 0; b < 2; ++b)
#pragma unroll
                for (int m = 0; m < 4; ++m)
#pragma unroll
                    for (int n = 0; n < 2; ++n) acc[a][b][m][n] = (f32x4){0.f, 0.f, 0.f, 0.f};
        cur = nxt; cA = nA; cB = nB; ++ui;
        if constexpr (ALIGN_EPI) { if (wr == 1) PG8_BAR; }
    }
    PG8_WAIT_V(0);
    if constexpr (!ALIGN_EPI) { if (wr == 0) PG8_BAR; }
    PG8_BAR;
#undef PG8_SA
#undef PG8_SB
#undef PG8_STAGE
#undef PG8_LDA
#undef PG8_LDB
#undef PG8_MMA
#undef PG8_WAIT_V
#undef PG8_WAIT_L
#undef PG8_BAR
#undef PG8_SCHED
}
}

#define GAS __attribute__((address_space(1)))
#define LAS __attribute__((address_space(3)))
typedef unsigned short bf16;
typedef unsigned v4u __attribute__((ext_vector_type(4)));
typedef unsigned v2u __attribute__((ext_vector_type(2)));
typedef float f32x4 __attribute__((ext_vector_type(4)));
typedef float f32x2 __attribute__((ext_vector_type(2)));
typedef short bf16x8 __attribute__((ext_vector_type(8)));
#define LDS_WAIT() asm volatile("s_waitcnt lgkmcnt(0)" ::: "memory")
#define VM_WAIT() asm volatile("s_waitcnt vmcnt(0)" ::: "memory")

__device__ __forceinline__ unsigned f2bf(float f) { unsigned u = __builtin_bit_cast(unsigned, f); return (u + 0x7fffu + ((u >> 16) & 1u)) >> 16; }
__device__ __forceinline__ unsigned pk2(float lo, float hi) { return pg8::cvt_pk_bf16(lo, hi); }
__device__ __forceinline__ float bflo(unsigned w) { return __builtin_bit_cast(float, w << 16); }
__device__ __forceinline__ float bfhi(unsigned w) { return __builtin_bit_cast(float, w & 0xffff0000u); }
__device__ __forceinline__ void unpack8(const v4u w, float (&f)[8]) { f[0] = bflo(w.x); f[1] = bfhi(w.x); f[2] = bflo(w.y); f[3] = bfhi(w.y); f[4] = bflo(w.z); f[5] = bfhi(w.z); f[6] = bflo(w.w); f[7] = bfhi(w.w); }
__device__ __forceinline__ v4u pack8(const float (&f)[8]) { v4u w; w.x = pk2(f[0], f[1]); w.y = pk2(f[2], f[3]); w.z = pk2(f[4], f[5]); w.w = pk2(f[6], f[7]); return w; }
__device__ __forceinline__ float fexp2(float x) { return __builtin_amdgcn_exp2f(x); }
__device__ __forceinline__ float fexp(float x) { return __builtin_amdgcn_exp2f(x * 1.4426950408889634f); }
__device__ __forceinline__ float frcp(float x) { return __builtin_amdgcn_rcpf(x); }
__device__ __forceinline__ float sigmoidf_(float x) { return frcp(1.0f + fexp(-x)); }
__device__ __forceinline__ float siluf_(float x) { return x * sigmoidf_(x); }
__device__ __forceinline__ float tanhf_(float x) { return 1.0f - 2.0f * frcp(1.0f + fexp(2.0f * x)); }
__device__ __forceinline__ float gelu_tanh(float x) { const float u = 1.5957691216057308f * (x + 0.044715f * x * x * x); return x * sigmoidf_(u); }
__device__ __forceinline__ float wave_sum(float v) {
#pragma unroll
    for (int o = 1; o < 64; o <<= 1) v += __shfl_xor(v, o);
    return v;
}
__device__ __forceinline__ int my_tid() { int t = threadIdx.x; asm volatile("" : "+v"(t)); return t; }
__device__ __forceinline__ float dpp_row(float x, const int sel) {
    const int xi = __builtin_bit_cast(int, x); int r;
    if (sel == 0) r = __builtin_amdgcn_update_dpp(0, xi, 0xB1, 0xF, 0xF, true);
    else if (sel == 1) r = __builtin_amdgcn_update_dpp(0, xi, 0x4E, 0xF, 0xF, true);
    else if (sel == 2) r = __builtin_amdgcn_update_dpp(0, xi, 0x141, 0xF, 0xF, true);
    else r = __builtin_amdgcn_update_dpp(0, xi, 0x140, 0xF, 0xF, true);
    return __builtin_bit_cast(float, r);
}
__device__ __forceinline__ float sum16(float x) { x += dpp_row(x, 0); x += dpp_row(x, 1); x += dpp_row(x, 2); x += dpp_row(x, 3); return x; }
__device__ __forceinline__ float dpp_f(float x, const int ctrl_sel) {
    const int xi = __builtin_bit_cast(int, x); int r;
    if (ctrl_sel == 0) r = __builtin_amdgcn_update_dpp(xi, xi, 0xB1, 0xF, 0xF, false);
    else if (ctrl_sel == 1) r = __builtin_amdgcn_update_dpp(xi, xi, 0x4E, 0xF, 0xF, false);
    else r = __builtin_amdgcn_update_dpp(xi, xi, 0x141, 0xF, 0xF, false);
    return __builtin_bit_cast(float, r);
}
__device__ __forceinline__ float sum8(float x) { x += dpp_f(x, 0); x += dpp_f(x, 1); x += dpp_f(x, 2); return x; }

#define XB_TMO      128
#define XB_XCNT(j)  (256  + 64 * (j))
#define XB_XSUB(j)  (1280 + 64 * (j))
#define XB_XGEN(j)  (2304 + 64 * (j))
#define XB_TOP      3328
#define XB_TOPGEN   3392
#define XCD_BAR_WORDS 3456
#define XB_SPIN_CAP (1u << 18)

__device__ __forceinline__ unsigned xb_ld(unsigned* p)              { return __hip_atomic_load(p, __ATOMIC_RELAXED, __HIP_MEMORY_SCOPE_AGENT); }
__device__ __forceinline__ unsigned xb_add(unsigned* p, unsigned v) { return __hip_atomic_fetch_add(p, v, __ATOMIC_RELAXED, __HIP_MEMORY_SCOPE_AGENT); }
__device__ __forceinline__ unsigned xb_xcc_id() { return (unsigned)__builtin_amdgcn_s_getreg((3 << 11) | 20) & 0xFu; }
#define XB_SPIN(cond, bar) do { unsigned _sp = 0; while (cond) { __builtin_amdgcn_s_sleep(1); \
    if ((++_sp & 255u) == 0u) { if (xb_ld(&(bar)[XB_TMO])) break; if (_sp > XB_SPIN_CAP) { atomicAdd(&(bar)[XB_TMO], 1u); break; } } } } while (0)

struct XcdBarrier {
    unsigned* bar; unsigned x;
    volatile LAS unsigned* st;
};
__device__ __forceinline__ XcdBarrier xcd_barrier_post(unsigned* bar, volatile LAS unsigned* st) {
    XcdBarrier b; b.bar = bar; b.x = xb_xcc_id(); b.st = st;
    if (threadIdx.x == 0) (void)xb_add(&bar[XB_XCNT(b.x)], 1u);
    return b;
}
__device__ __forceinline__ void xcd_barrier_complete(unsigned* bar, unsigned x, unsigned& nloc, unsigned& nx) {
    const unsigned G = gridDim.x * gridDim.y * gridDim.z;
    unsigned sum, cnt, mine, sp = 0u;
    for (;;) {
        sum = 0u; cnt = 0u; mine = 0u;
#pragma unroll
        for (unsigned j = 0; j < 16; ++j) { const unsigned c = xb_ld(&bar[XB_XCNT(j)]); sum += c; cnt += (c > 0u) ? 1u : 0u; mine = (j == x) ? c : mine; }
        if (sum == G) break;
        __builtin_amdgcn_s_sleep(1);
        if ((++sp & 255u) == 0u) { if (xb_ld(&bar[XB_TMO])) break; if (sp > XB_SPIN_CAP) { atomicAdd(&bar[XB_TMO], 1u); break; } }
    }
    nloc = mine > 0u ? mine : 1u; nx = cnt > 0u ? cnt : 1u;
}
__device__ __forceinline__ void xcd_barrier(const XcdBarrier& b) {
    asm volatile("s_waitcnt vmcnt(0)" ::: "memory");
    __syncthreads();
    if (threadIdx.x == 0) {
        unsigned* bar = b.bar;
        __builtin_amdgcn_s_waitcnt(0);
        unsigned nloc = b.st[0], nx = b.st[1];
        if (nloc == 0u) { xcd_barrier_complete(bar, b.x, nloc, nx); b.st[0] = nloc; b.st[1] = nx; }
        const unsigned old = xb_add(&bar[XB_XSUB(b.x)], 1u);
        const unsigned gen = old / nloc;
        if (old + 1u == (gen + 1u) * nloc) {
            __builtin_amdgcn_fence(__ATOMIC_RELEASE, "agent");
            asm volatile("s_waitcnt vmcnt(0)" ::: "memory");
            const unsigned og = xb_add(&bar[XB_TOP], 1u);
            const unsigned tg = og / nx;
            if (og + 1u == (tg + 1u) * nx) xb_add(&bar[XB_TOPGEN], 1u);
            else XB_SPIN(xb_ld(&bar[XB_TOPGEN]) == tg, bar);
            __builtin_amdgcn_fence(__ATOMIC_ACQUIRE, "agent");
            xb_add(&bar[XB_XGEN(b.x)], 1u);
            asm volatile("s_waitcnt vmcnt(0)" ::: "memory");
        } else {
            XB_SPIN(xb_ld(&bar[XB_XGEN(b.x)]) == gen, bar);
            __builtin_amdgcn_fence(__ATOMIC_ACQUIRE, "agent");
            asm volatile("s_waitcnt vmcnt(0)" ::: "memory");
        }
    }
    __syncthreads();
}

constexpr int NWAVES = 8, NTHREADS = 512;
constexpr int D = 4096, BATCH = 2, SEQ = 8192, CTXL = 256;
constexpr int MLAT = BATCH * SEQ;
constexpr int MCTX = BATCH * CTXL;
constexpr int MALL = MLAT + MCTX;
constexpr int AB_IN = 13696, ZLD = 13824;
constexpr int ZQ = 0, ZK = 2048, ZV = 2560, ZGA = 3072, ZR = 5120, ZKB = 7168, ZVB = 9216, ZGB = 11264, ZDL = 13312, ZAL = 13504;
constexpr int BW = 2048;
constexpr int CW = 12288;
constexpr int VTLD = SEQ + CTXL;
constexpr int NPHASE = 14;

constexpr size_t MiB = 1u << 20;
constexpr size_t WS_CTL   = 0;
constexpr size_t CTL_ZERO_BYTES = 1 * MiB;
constexpr size_t WS_MODV  = 1 * MiB;
constexpr size_t WS_ROPE  = WS_MODV + 512 * 1024;
constexpr size_t WS_STATS = WS_ROPE + 64 * 1024;
constexpr size_t WS_WSB   = 2 * MiB;
constexpr size_t WS_WLORA = 3 * MiB;
constexpr size_t WS_WOUT0 = 9 * MiB;
constexpr size_t WS_WGOUT = 41 * MiB;
constexpr size_t WS_WGIN  = 137 * MiB;
constexpr size_t WS_H     = 425 * MiB;
constexpr size_t WS_YS    = WS_H;
constexpr size_t WS_X1    = 557 * MiB;
constexpr size_t WS_OAB   = 813 * MiB;
constexpr size_t WS_WIN0  = 941 * MiB;
constexpr size_t WS_VTA   = 1049 * MiB;
constexpr size_t WS_Z     = 1066 * MiB;
constexpr size_t WS_RKVK  = 1512 * MiB;
constexpr size_t WS_EKK   = 1776 * MiB;
constexpr size_t WS_END   = 2172 * MiB;
constexpr size_t WS_Y0    = WS_Z;
constexpr size_t WS_Y1    = WS_Z;
constexpr size_t WS_VT    = WS_Z;
constexpr size_t WS_STATP = WS_RKVK;
constexpr size_t WS_Y     = WS_EKK;
static_assert(WS_WLORA + (size_t)8192 * 384 * 2 <= WS_WOUT0 && WS_WOUT0 + (size_t)D * D * 2 <= WS_WGOUT && WS_WGOUT + (size_t)D * CW * 2 <= WS_WGIN && WS_WGIN + (size_t)3 * CW * D * 2 <= WS_H, "ws map 1");
static_assert(WS_H + (size_t)MALL * D * 2 <= WS_X1 && WS_X1 + (size_t)MLAT * D * 4 <= WS_OAB && WS_OAB + (size_t)MLAT * D * 2 <= WS_WIN0 && WS_WIN0 + (size_t)ZLD * D * 2 <= WS_VTA, "ws map 2");
static_assert(WS_VTA + (size_t)2 * 4 * 128 * VTLD * 2 <= WS_Z && WS_Z + (size_t)MALL * ZLD * 2 <= WS_RKVK && WS_RKVK + (size_t)4 * MALL * BW * 2 <= WS_EKK && WS_EKK + (size_t)6 * MALL * BW * 2 <= WS_END, "ws map 3");
static_assert(WS_VT + (size_t)CW * MLAT * 2 <= WS_RKVK && WS_STATP + (size_t)MLAT * 192 * 8 <= WS_EKK && WS_Y + (size_t)MLAT * CW * 2 <= WS_END && WS_END <= (size_t)2304 * MiB, "ws map 4");
constexpr int CW_BAR = 4096;

constexpr int RING_BYTES = 131072;
constexpr int LDS_BYTES = 147456;
constexpr int LDSCTL_OFF = LDS_BYTES - 256;

struct Args { const float* in[27]; float* out; unsigned char* ws; int ph_lo, ph_hi; };

enum { I_X = 0, I_C, I_CTX, I_CCTX, I_MODW, I_MODB, I_NORMG, I_WIN, I_WOUT, I_SINK, I_CONV, I_W0, I_W2, I_A0, I_A2, I_KK, I_KA, I_RK, I_GNW, I_GNB,
       I_GWIN, I_LNG, I_LNB, I_WS, I_BS, I_GWOUT, I_FING };

__device__ __forceinline__ int src_col(int mat, int c) {
    if (mat == 0) {
        if (c >= ZDL) { const int kind = (c - ZDL) >> 7, r = (c - ZDL) & 127; return r < 96 ? ZDL + kind * 96 + r : -1; }
        if (c < ZV) { const int head = c >> 7, p = c & 127, qq = 4 * (p >> 3) + (p & 3), n = (p >> 2) & 1; return (head << 7) + qq + (qq >= 32 ? 32 : 0) + 32 * n; }
        return c;
    }
    if (mat == 2) {
        if (c < CW) return CW + c;
        const int cc = c - CW, tile = cc >> 8, w = cc & 255;
        return w < 128 ? (tile * 128 + w) : (2 * CW + tile * 128 + (w - 128));
    }
    return c;
}
__device__ __forceinline__ void tr_load(const float* W, int N, int mat, int item, int lane, int nblk, float (&x)[32]) {
    const int kb = item / nblk, nb = item % nblk, k0 = 64 * kb, n0 = 32 * nb;
    const int sc = src_col(mat, n0 + (lane & 31));
#pragma unroll
    for (int i = 0; i < 32; ++i) { const int kk = 2 * i + (lane >> 5); x[i] = sc >= 0 ? W[(size_t)(k0 + kk) * N + sc] : 0.f; }
}
__device__ __forceinline__ void tr_load_nc(const float* W, int N, int mat, int item, int lane, int nblk, float (&x)[32]) {
    const int kb = item / nblk, nb = item % nblk, k0 = 64 * kb, n0 = 32 * nb;
    const int sc = src_col(mat, n0 + (lane & 31));
    const float* wp = W + (size_t)(k0 + (lane >> 5)) * N + sc;
#pragma unroll
    for (int i = 0; i < 32; ++i) x[i] = wp[(size_t)(2 * i) * N];
}
__device__ __forceinline__ void tr_store(bf16* WT, int K, LAS float* scr, int item, int lane, int nblk, const float (&x)[32]) {
    const int kb = item / nblk, nb = item % nblk, k0 = 64 * kb, n0 = 32 * nb;
#pragma unroll
    for (int i = 0; i < 32; ++i) { const int kk = 2 * i + (lane >> 5); scr[kk * 33 + (lane & 31)] = x[i]; }
    LDS_WAIT(); asm volatile("" ::: "memory");
    const int c = lane & 7;
#pragma unroll
    for (int j = 0; j < 4; ++j) { const int n = (lane >> 3) + 8 * j; const LAS float* s = scr + (8 * c) * 33 + n;
        v4u o; o.x = pk2(s[0 * 33], s[1 * 33]); o.y = pk2(s[2 * 33], s[3 * 33]); o.z = pk2(s[4 * 33], s[5 * 33]); o.w = pk2(s[6 * 33], s[7 * 33]);
        *(GAS v4u*)(WT + (size_t)(n0 + n) * K + k0 + 8 * c) = o; }
    LDS_WAIT(); asm volatile("" ::: "memory");
}
__device__ __forceinline__ void p0_transpose_item(const float* W, int K, int N, bf16* WT, int mat, LAS float* scr, int item, int lane, int nblk) {
    float x[32]; tr_load(W, N, mat, item, lane, nblk, x); tr_store(WT, K, scr, item, lane, nblk, x);
}
constexpr int TR_NB0 = ZLD / 32, TR_NB1 = D / 32, TR_NB2 = 3 * CW / 32, TR_NB3 = D / 32;
constexpr int L1_P5 = 24576;
constexpr int ATT_P5 = 1024;
constexpr int TR_I0 = (D / 64) * TR_NB0, TR_I1 = (D / 64) * TR_NB1, TR_I2 = (D / 64) * TR_NB2, TR_I3 = (CW / 64) * TR_NB3;
__device__ __forceinline__ void l1_load(const Args& a, int j, int lane, float (&x)[32]) {
    if (j < TR_I2) tr_load(a.in[I_GWIN], 3 * CW, 2, j, lane, TR_NB2, x); else tr_load(a.in[I_GWOUT], D, 3, j - TR_I2, lane, TR_NB3, x);
}
__device__ __forceinline__ void l1_store(const Args& a, int j, int lane, LAS float* scr, const float (&x)[32]) {
    if (j < TR_I2) tr_store((bf16*)(a.ws + WS_WGIN), D, scr, j, lane, TR_NB2, x); else tr_store((bf16*)(a.ws + WS_WGOUT), CW, scr, j - TR_I2, lane, TR_NB3, x);
}
__device__ __forceinline__ void p0_phase(const Args& a, LAS unsigned char* lds) {
    const int tid = my_tid(), lane = tid & 63, wave = __builtin_amdgcn_readfirstlane(tid >> 6);
    unsigned char* ws = a.ws;
    const int G = gridDim.x, bx = blockIdx.x;
    {
        LAS float* sc = (LAS float*)lds;
        LAS float* red = (LAS float*)(lds + 49152);
        for (int i = tid; i < 3 * D; i += NTHREADS) { const int j = i / D, k = i % D; const float v = j < 2 ? a.in[I_C][j * D + k] : a.in[I_CCTX][k]; sc[i] = siluf_(v); }
        __syncthreads();
        float* modv = (float*)(ws + WS_MODV);
        for (int item = bx; item < 256; item += G) {
            const int l = item >> 7, cb = (item & 127) * 96;
            const float* W = a.in[I_MODW] + (size_t)l * D * 3 * D;
            if (tid < 384) {
                const int cg = tid % 24, ks = tid / 24;
                f32x4 a0 = {0.f, 0.f, 0.f, 0.f}, a1 = a0, a2 = a0;
                const float* wp = W + (size_t)(ks * 256) * (3 * D) + cb + 4 * cg;
#pragma unroll 32
                for (int r = 0; r < 256; ++r) {
                    const f32x4 w = *(const GAS f32x4*)(wp + (size_t)r * (3 * D));
                    const int k = ks * 256 + r;
                    a0 += w * sc[k]; a1 += w * sc[D + k]; a2 += w * sc[2 * D + k];
                }
                LAS float* rp = red + (ks * 24 + cg) * 12;
                *(LAS f32x4*)(rp) = a0; *(LAS f32x4*)(rp + 4) = a1; *(LAS f32x4*)(rp + 8) = a2;
            }
            __syncthreads();
            if (tid < 288) {
                const int j = tid / 96, col = tid % 96, cg = col >> 2, e = col & 3;
                float s = 0.f;
#pragma unroll
                for (int ks = 0; ks < 16; ++ks) s += red[(ks * 24 + cg) * 12 + j * 4 + e];
                modv[((size_t)l * 3 + j) * (3 * D) + cb + col] = s + a.in[I_MODB][(size_t)l * 3 * D + cb + col];
            }
            __syncthreads();
        }
    }
    {
        LAS float* scr = (LAS float*)(lds + wave * 16384);
        const int gw = bx * NWAVES + wave, NGW = G * NWAVES;
        constexpr int P0_ITEMS = TR_I0 + TR_I1 + (TR_I2 + TR_I3 - L1_P5);
        auto p0_load = [&](int it, float (&x)[32]) { if (it < TR_I0) tr_load(a.in[I_WIN], AB_IN, 0, it, lane, TR_NB0, x); else if (it < TR_I0 + TR_I1) tr_load(a.in[I_WOUT], D, 1, it - TR_I0, lane, TR_NB1, x); else l1_load(a, it - TR_I0 - TR_I1 + L1_P5, lane, x); };
        auto p0_store = [&](int it, const float (&x)[32]) { if (it < TR_I0) tr_store((bf16*)(ws + WS_WIN0), D, scr, it, lane, TR_NB0, x); else if (it < TR_I0 + TR_I1) tr_store((bf16*)(ws + WS_WOUT0), D, scr, it - TR_I0, lane, TR_NB1, x); else l1_store(a, it - TR_I0 - TR_I1 + L1_P5, lane, scr, x); };
        float x[32], xn[32];
        int it = gw;
        if (it < P0_ITEMS) p0_load(it, x);
        while (it < P0_ITEMS) {
            const int itn = it + NGW;
            if (itn < P0_ITEMS) p0_load(itn, xn);
            p0_store(it, x);
#pragma unroll
            for (int i = 0; i < 32; ++i) x[i] = xn[i];
            it = itn;
        }
    }
    {
        const size_t gt = (size_t)bx * NTHREADS + tid, GT = (size_t)G * NTHREADS;
        bf16* wl = (bf16*)(ws + WS_WLORA);
        for (size_t i = gt; i < (size_t)8192 * 128; i += GT) {
            const int n = (int)(i >> 7), r = (int)(i & 127), kind = n >> 11, c = n & 2047, dir = kind & 1;
            float v = 0.f;
            if (r < 96) { const float* src = (kind < 2) ? a.in[I_W2] : a.in[I_A2]; v = src[((size_t)dir * 96 + r) * BW + c]; }
            wl[i] = (bf16)f2bf(v);
        }
        bf16* wsb = (bf16*)(ws + WS_WSB);
        for (size_t i = gt; i < (size_t)16 * 128 * 128; i += GT) wsb[i] = (bf16)f2bf(a.in[I_WS][i]);
        float* rope = (float*)(ws + WS_ROPE);
        for (size_t i = gt; i < (size_t)128 * 32; i += GT) {
            const int pos = (int)(i >> 5), f = (int)(i & 31);
            const float inv = powf(10000.0f, -(float)f / 32.0f); const float ang = (float)pos * inv;
            rope[i] = cosf(ang); rope[4096 + i] = sinf(ang);
        }
    }
}

__device__ __forceinline__ void norm_phase(const Args& a, LAS unsigned char* lds, int layer, const float* xlat, const float* xctx, int nrows, const bf16* yadd, bf16* xout) {
    const int tid = my_tid(), lane = tid & 63, wave = __builtin_amdgcn_readfirstlane(tid >> 6);
    LAS float* gs = (LAS float*)lds; LAS float* sh = (LAS float*)(lds + 49152);
    const float* modv = (const float*)(a.ws + WS_MODV) + (size_t)layer * 3 * 3 * D;
    const float* g = a.in[I_NORMG] + (size_t)layer * D;
#pragma unroll 8
    for (int i = tid; i < 3 * D; i += NTHREADS) { const int j = i / D, k = i % D; gs[i] = g[k] * (1.0f + modv[(size_t)j * 3 * D + D + k]); sh[i] = modv[(size_t)j * 3 * D + k]; }
    __syncthreads();
    bf16* H = (bf16*)(a.ws + WS_H);
    const int gw = blockIdx.x * NWAVES + wave, NGW = gridDim.x * NWAVES;
    f32x4 v[16], vn[16]; v2u yv[16], yn[16];
    auto loadrow = [&](int row, f32x4 (&dst)[16], v2u (&yd)[16]) {
        const float* xr = (row < MLAT) ? xlat + (size_t)row * D : xctx + (size_t)(row - MLAT) * D;
        const GAS f32x4* xp = (const GAS f32x4*)xr + lane;
#pragma unroll
        for (int q = 0; q < 16; ++q) dst[q] = xp[64 * q];
        if (yadd) { const GAS v2u* yp = (const GAS v2u*)(yadd + (size_t)row * D) + lane;
#pragma unroll
            for (int q = 0; q < 16; ++q) yd[q] = yp[64 * q]; }
    };
    int row = gw;
    if (row < nrows) loadrow(row, v, yv);
    while (row < nrows) {
        const int nrow = row + NGW;
        if (nrow < nrows) loadrow(nrow, vn, yn);
        const int j = (row < MLAT) ? (row >> 13) : 2;
        float s = 0.f;
        if (yadd) {
            GAS v2u* xo = (GAS v2u*)(xout + (size_t)row * D) + lane;
#pragma unroll
            for (int q = 0; q < 16; ++q) { v[q] += (f32x4){bflo(yv[q].x), bfhi(yv[q].x), bflo(yv[q].y), bfhi(yv[q].y)}; v2u w; w.x = pk2(v[q].x, v[q].y); w.y = pk2(v[q].z, v[q].w); xo[64 * q] = w; }
        }
#pragma unroll
        for (int q = 0; q < 16; ++q) s += (v[q].x * v[q].x + v[q].y * v[q].y) + (v[q].z * v[q].z + v[q].w * v[q].w);
        const float rstd = 1.0f / sqrtf(wave_sum(s) * (1.0f / D) + 1e-6f);
        GAS v2u* op = (GAS v2u*)(H + (size_t)row * D) + lane;
#pragma unroll
        for (int q = 0; q < 16; ++q) {
            const int c = 4 * lane + 256 * q;
            const f32x4 gg = *(const LAS f32x4*)(gs + j * D + c), ss = *(const LAS f32x4*)(sh + j * D + c);
            const f32x4 o = v[q] * rstd * gg + ss;
            v2u w; w.x = pk2(o.x, o.y); w.y = pk2(o.z, o.w); op[64 * q] = w;
        }
#pragma unroll
        for (int q = 0; q < 16; ++q) { v[q] = vn[q]; yv[q] = yn[q]; }
        row = nrow;
    }
}

typedef pg8::f32x4 af4;
struct EpiNull { static constexpr bool PERM = true; __device__ __forceinline__ void operator()(const af4 (&acc)[2][2][4][2], const pg8::Unit& u, int wr, int wc, int fr, int fq) const {
    af4 s = {0.f, 0.f, 0.f, 0.f};
#pragma unroll
    for (int a = 0; a < 2; ++a)
#pragma unroll
        for (int b = 0; b < 2; ++b)
#pragma unroll
            for (int m = 0; m < 4; ++m)
#pragma unroll
                for (int n = 0; n < 2; ++n) s += acc[a][b][m][n];
    if (s[0] + s[1] + s[2] + s[3] == 123.456f) *(GAS float*)nullptr = 0.f; } };
struct EpiZ {
    static constexpr bool PERM = true;
    bf16* Z; bf16* VTA; const float* rope;
    __device__ __forceinline__ void operator()(const af4 (&acc)[2][2][4][2], const pg8::Unit& u, int wr, int wc, int fr, int fq) const {
        const int pn = u.pn, row0 = u.pm * 256 + wr * 64 + fr, col0 = pn * 256 + wc * 32 + 8 * fq;
        if (pn < 10 && u.pm < 64) {
            const float qs = (pn < 8) ? 0.08838834764831845f * 1.4426950408889634f : 1.0f;
            const int fbase = 16 * (wc & 1) + 4 * fq;
#pragma unroll
            for (int ai = 0; ai < 2; ++ai)
#pragma unroll
                for (int m = 0; m < 4; ++m) {
                    const int row = row0 + ai * 128 + m * 16, t = row & (SEQ - 1), pos = (wc < 2) ? (t >> 6) : (t & 63);
                    const af4 cs = *(const GAS af4*)(rope + pos * 32 + fbase), sn = *(const GAS af4*)(rope + 4096 + pos * 32 + fbase);
                    bf16* rowp = Z + (size_t)row * ZLD + col0;
#pragma unroll
                    for (int bj = 0; bj < 2; ++bj) {
                        const af4 x1 = acc[ai][bj][m][0], x2 = acc[ai][bj][m][1];
                        const af4 o1 = (x1 * cs - x2 * sn) * qs, o2 = (x2 * cs + x1 * sn) * qs;
                        v4u w; w.x = pk2(o1[0], o1[1]); w.y = pk2(o1[2], o1[3]); w.z = pk2(o2[0], o2[1]); w.w = pk2(o2[2], o2[3]);
                        *(GAS v4u*)(rowp + bj * 128) = w;
                    }
                }
        } else if (pn == 10 || pn == 11) {
#pragma unroll
            for (int ai = 0; ai < 2; ++ai)
#pragma unroll
                for (int m = 0; m < 4; ++m) {
                    const int row = row0 + ai * 128 + m * 16;
                    int b, tpos;
                    if (row < MLAT) { b = row >> 13; tpos = row & (SEQ - 1); } else { const int rr = row - MLAT; b = rr >> 8; tpos = SEQ + (rr & 255); }
                    const int k32 = tpos & 31, sp = (tpos & ~31) + ((k32 < 16) ? (8 * (k32 >> 2) + (k32 & 3)) : (8 * ((k32 - 16) >> 2) + 4 + (k32 & 3)));
#pragma unroll
                    for (int bj = 0; bj < 2; ++bj) {
                        const int hk = (pn - 10) * 2 + bj;
                        bf16* vp = VTA + ((size_t)(b * 4 + hk) * 128 + wc * 32 + 8 * fq) * VTLD + sp;
#pragma unroll
                        for (int n = 0; n < 2; ++n)
#pragma unroll
                            for (int e = 0; e < 4; ++e) vp[(size_t)(4 * n + e) * VTLD] = (bf16)f2bf(acc[ai][bj][m][n][e]);
                    }
                }
        } else {
            const bool th0 = (pn == 52), th1 = (pn == 52);
#pragma unroll
            for (int ai = 0; ai < 2; ++ai)
#pragma unroll
                for (int m = 0; m < 4; ++m) {
                    bf16* rowp = Z + (size_t)(row0 + ai * 128 + m * 16) * ZLD + col0;
#pragma unroll
                    for (int bj = 0; bj < 2; ++bj) {
                        af4 v0 = acc[ai][bj][m][0], v1 = acc[ai][bj][m][1];
                        if (bj == 0 ? th0 : th1) {
#pragma unroll
                            for (int e = 0; e < 4; ++e) { v0[e] = tanhf_(v0[e]); v1[e] = tanhf_(v1[e]); }
                        }
                        v4u w; w.x = pk2(v0[0], v0[1]); w.y = pk2(v0[2], v0[3]); w.z = pk2(v1[0], v1[1]); w.w = pk2(v1[2], v1[3]);
                        *(GAS v4u*)(rowp + bj * 128) = w;
                    }
                }
        }
    }
};
struct EpiLora {
    static constexpr bool PERM = true;
    const float *w0, *a0; bf16 *EA;
    __device__ __forceinline__ void operator()(const af4 (&acc)[2][2][4][2], const pg8::Unit& u, int wr, int wc, int fr, int fq) const {
        const int kind = u.pn >> 3, dir = kind & 1, cb = (u.pn & 7) * 256 + wc * 32 + 8 * fq, row0 = u.pm * 256 + wr * 64 + fr;
        const float* bias = (kind < 2 ? w0 : a0) + dir * BW;
        const float sc = kind < 2 ? 0.6065306597126334f * 1.4426950408889634f : 1.0f;
#pragma unroll
        for (int bj = 0; bj < 2; ++bj) {
            const int c = cb + bj * 128;
            const af4 bb[2] = {*(const GAS af4*)(bias + c) * -1.4426950408889634f, *(const GAS af4*)(bias + c + 4) * -1.4426950408889634f};
#pragma unroll
            for (int ai = 0; ai < 2; ++ai)
#pragma unroll
                for (int m = 0; m < 4; ++m) {
                    const int row = row0 + ai * 128 + m * 16;
                    float o[8];
#pragma unroll
                    for (int n = 0; n < 2; ++n)
#pragma unroll
                        for (int e = 0; e < 4; e += 2) {
                            const f32x2 x = {acc[ai][bj][m][n][e], acc[ai][bj][m][n][e + 1]};
                            const f32x2 ar = x * -1.4426950408889634f + (f32x2){bb[n][e], bb[n][e + 1]};
                            const f32x2 den = (f32x2){fexp2(ar.x), fexp2(ar.y)} + 1.0f;
                            const f32x2 r = (f32x2){frcp(den.x), frcp(den.y)} * sc;
                            o[4 * n + e] = r.x; o[4 * n + e + 1] = r.y; }
                    *(GAS v4u*)(EA + ((size_t)kind * MALL + row) * BW + c) = pack8(o);
                }
        }
    }
};
struct EpiGateOut {
    static constexpr bool PERM = true;
    bf16* Y; const float* gate;
    __device__ __forceinline__ void operator()(const af4 (&acc)[2][2][4][2], const pg8::Unit& u, int wr, int wc, int fr, int fq) const {
        const int row0 = u.pm * 256 + wr * 64 + fr, col0 = u.pn * 256 + wc * 32 + 8 * fq;
        const float* gp = gate + (size_t)(u.pm >> 5) * 3 * D + col0;
        af4 gv[2][2];
#pragma unroll
        for (int bj = 0; bj < 2; ++bj)
#pragma unroll
            for (int n = 0; n < 2; ++n) gv[bj][n] = *(const GAS af4*)(gp + bj * 128 + n * 4);
#pragma unroll
        for (int ai = 0; ai < 2; ++ai)
#pragma unroll
            for (int m = 0; m < 4; ++m) {
                bf16* rowp = Y + (size_t)(row0 + ai * 128 + m * 16) * D + col0;
#pragma unroll
                for (int bj = 0; bj < 2; ++bj) {
                    const af4 v0 = acc[ai][bj][m][0] * gv[bj][0], v1 = acc[ai][bj][m][1] * gv[bj][1];
                    v4u w; w.x = pk2(v0[0], v0[1]); w.y = pk2(v0[2], v0[3]); w.z = pk2(v1[0], v1[1]); w.w = pk2(v1[2], v1[3]);
                    *(GAS v4u*)(rowp + bj * 128) = w;
                }
            }
    }
};
struct EpiVT {
    static constexpr bool PERM = true;
    bf16* VT; float* statp;
    __device__ __forceinline__ void operator()(const af4 (&acc)[2][2][4][2], const pg8::Unit& u, int wr, int wc, int fr, int fq) const {
        const int row0 = u.pm * 256 + wr * 64 + fr, col0 = u.pn * 256 + wc * 32 + 8 * fq;
#pragma unroll
        for (int bj = 0; bj < 2; ++bj) {
            f32x2 p1[4], p2[4];
#pragma unroll
            for (int i = 0; i < 4; ++i) { p1[i] = (f32x2){0.f, 0.f}; p2[i] = (f32x2){0.f, 0.f}; }
#pragma unroll
            for (int ai = 0; ai < 2; ++ai)
#pragma unroll
                for (int m = 0; m < 4; ++m) {
                    float o[8];
#pragma unroll
                    for (int n = 0; n < 2; ++n)
#pragma unroll
                        for (int e = 0; e < 4; e += 2) {
                            const f32x2 x = {acc[ai][bj][m][n][e], acc[ai][bj][m][n][e + 1]};
                            const f32x2 ar = x * (x * x * (-2.302208198f * 0.044715f) + (-2.302208198f));
                            const f32x2 den = (f32x2){fexp2(ar.x), fexp2(ar.y)} + 1.0f;
                            const f32x2 gv = x * (f32x2){frcp(den.x), frcp(den.y)};
                            o[4 * n + e] = gv.x; o[4 * n + e + 1] = gv.y; p1[2 * n + (e >> 1)] += gv; p2[2 * n + (e >> 1)] += gv * gv; }
                    *(GAS v4u*)(VT + (size_t)(row0 + ai * 128 + m * 16) * MLAT + col0 + bj * 128) = pack8(o);
                }
            float s1[8], s2[8];
#pragma unroll
            for (int i = 0; i < 4; ++i) { s1[2 * i] = p1[i].x; s1[2 * i + 1] = p1[i].y; s2[2 * i] = p2[i].x; s2[2 * i + 1] = p2[i].y; }
#pragma unroll
            for (int e = 0; e < 8; ++e) { s1[e] = sum16(s1[e]); s2[e] = sum16(s2[e]); }
            if (fr == 0) {
#pragma unroll
                for (int e = 0; e < 8; ++e) *(GAS f32x2*)(statp + ((size_t)(col0 + bj * 128 + e) * 96 + u.pm * 2 + wr) * 2) = (f32x2){s1[e], s2[e]};
            }
            asm volatile("" ::: "memory");
        }
    }
};
struct EpiGate {
    static constexpr bool PERM = true;
    const bf16* VT; const float* stats; const bf16* wsb; const float *bs, *lng, *lnb; bf16* Y;
    __device__ __forceinline__ void operator()(const af4 (&acc)[2][2][4][2], const pg8::Unit& u, int wr_, int wc_, int fr_, int fq_) const {
        const int tid = my_tid(), lane = tid & 63, wid = __builtin_amdgcn_readfirstlane(tid >> 6), wr = wid >> 2, wc = wid & 3, fr = lane & 15, fq = lane >> 4;
        (void)wr_; (void)wc_; (void)fr_; (void)fq_;
        const int chbase = u.pn * 128, grp = u.pn / 6;
        const bf16* wsg = wsb + (size_t)grp * 128 * 128;
        const int chl = chbase + 32 * wc + 8 * (fr >> 2) + (fr & 3);
        float lg[2], lb[2];
#pragma unroll
        for (int n = 0; n < 2; ++n) { lg[n] = lng[chl + 4 * n]; lb[n] = lnb[chl + 4 * n]; }
        v4u raw[2][4];
        auto load_raw = [&](int ai) {
#pragma unroll
            for (int ks = 0; ks < 4; ++ks)
#pragma unroll
                for (int n = 0; n < 2; ++n) raw[n][ks] = *(const GAS v4u*)(VT + (size_t)(chl + 4 * n) * MLAT + u.pm * 256 + ai * 128 + 32 * ks + 8 * fq);
        };
        load_raw(0);
#pragma unroll
        for (int ai = 0; ai < 2; ++ai) {
            const int tok0 = u.pm * 256 + ai * 128;
            bf16x8 av[2][4];
#pragma unroll
            for (int ks = 0; ks < 4; ++ks) {
                const int j0 = tok0 + 32 * ks + 8 * fq;
                f32x4 st[4];
#pragma unroll
                for (int q = 0; q < 4; ++q) st[q] = *(const GAS f32x4*)(stats + (size_t)(j0 + 2 * q) * 2);
#pragma unroll
                for (int n = 0; n < 2; ++n) {
                    float vf[8];
                    unpack8(raw[n][ks], vf);
#pragma unroll
                    for (int q = 0; q < 4; ++q) { f32x2 t = {vf[2 * q], vf[2 * q + 1]}; t = t * (f32x2){st[q].z, st[q].w} + (f32x2){st[q].x, st[q].y}; t = t * lg[n] + lb[n]; vf[2 * q] = t.x; vf[2 * q + 1] = t.y; }
                    av[n][ks] = __builtin_bit_cast(bf16x8, pack8(vf));
                }
            }
#pragma unroll
            for (int m = 0; m < 4; ++m) {
                if (ai == 0 && m == 0) load_raw(1);
                const int it = wr * 64 + m * 16 + fr;
                bf16x8 wf[4];
#pragma unroll
                for (int ks = 0; ks < 4; ++ks) wf[ks] = *(const GAS bf16x8*)(wsg + (size_t)it * 128 + 32 * ks + 8 * fq);
                const float bsi = bs[grp * 128 + it];
                af4 vm[2] = {(af4){bsi, bsi, bsi, bsi}, (af4){bsi, bsi, bsi, bsi}};
#pragma unroll
                for (int ks = 0; ks < 4; ++ks) {
#pragma unroll
                    for (int n = 0; n < 2; ++n) vm[n] = __builtin_amdgcn_mfma_f32_16x16x32_bf16(av[n][ks], wf[ks], vm[n], 0, 0, 0);
                }
                float o[8];
#pragma unroll
                for (int n = 0; n < 2; ++n)
#pragma unroll
                    for (int e = 0; e < 4; e += 2) {
                        const f32x2 uu = {acc[ai][0][m][n][e], acc[ai][0][m][n][e + 1]}, gg = {acc[ai][1][m][n][e], acc[ai][1][m][n][e + 1]}, vv = {vm[n][e], vm[n][e + 1]};
                        const f32x2 ar = uu * (uu * uu * (-2.302208198f * 0.044715f) + (-2.302208198f));
                        const f32x2 gs = gg * (-1.4426950408889634f);
                        const f32x2 ea = {fexp2(ar.x), fexp2(ar.y)}, eb = {fexp2(gs.x), fexp2(gs.y)};
                        const f32x2 q = eb + 1.0f, den = ea * q + q;
                        const f32x2 r = {frcp(den.x), frcp(den.y)};
                        const f32x2 w = (uu * gg) * vv * r;
                        o[4 * n + e] = w.x; o[4 * n + e + 1] = w.y; }
                *(GAS v4u*)(Y + (size_t)(tok0 + it) * CW + chbase + 32 * wc + 8 * fq) = pack8(o);
            }
        }
        (void)lane;
    }
};

constexpr int AK_STRIDE = 320, AV_STRIDE = 192, AK_BYTES = 64 * AK_STRIDE, AV_BYTES = 128 * AV_STRIDE, ATT_BUF = AK_BYTES + AV_BYTES;
__device__ __forceinline__ void attn_unit(const Args& a, LAS unsigned char* lds, int unit, int tid, int lane, int wave) {
    const bf16* Z = (const bf16*)(a.ws + WS_Z); const bf16* VTA = (const bf16*)(a.ws + WS_VTA); bf16* OAB = (bf16*)(a.ws + WS_OAB);
    const int hp = unit & 1, hk = (unit >> 1) & 3, nblk = (unit >> 3) & 63, b = unit >> 9;
    const int hq = 4 * hk + 2 * hp + (wave >> 2), qoff = 32 * (wave & 3);
    const int c16 = lane & 15, g = lane >> 4;
    bf16x8 qf[2][4];
#pragma unroll
    for (int qt = 0; qt < 2; ++qt) {
        const size_t row = (size_t)b * SEQ + nblk * 128 + qoff + 16 * qt + c16;
#pragma unroll
        for (int ks = 0; ks < 4; ++ks) qf[qt][ks] = *(const GAS bf16x8*)(Z + row * ZLD + ZQ + hq * 128 + 32 * ks + 8 * g);
    }
    const float sinkl2 = a.in[I_SINK][hq] * 1.4426950408889634f;
    float mrun[2] = {sinkl2, sinkl2}, lpart[2] = {0.f, 0.f};
    af4 O[2][8];
#pragma unroll
    for (int qt = 0; qt < 2; ++qt)
#pragma unroll
        for (int dt = 0; dt < 8; ++dt) O[qt][dt] = (af4){0.f, 0.f, 0.f, 0.f};
    const bf16* vtb = VTA + (size_t)(b * 4 + hk) * 128 * VTLD;
    auto step_valid = [&](int st) -> bool { if (st < 4) return true; const int nb = nblk - 1 + ((st - 4) >> 1); return nb >= 0 && nb <= 63; };
    auto step_geo = [&](int st, int& krow0, int& tpos0, int& kk0) {
        if (st < 4) { krow0 = MLAT + b * CTXL + 64 * st; tpos0 = SEQ + 64 * st; kk0 = 0; }
        else { const int bi = (st - 4) >> 1, hf = (st - 4) & 1, nb = nblk - 1 + bi; krow0 = b * SEQ + nb * 128 + 64 * hf; tpos0 = nb * 128 + 64 * hf; kk0 = bi * 128 + 64 * hf; } };
    v4u pk0, pk1, pv0, pv1;
    auto issue = [&](int st) { int krow0, tpos0, kk0; step_geo(st, krow0, tpos0, kk0);
        const bf16* kp = Z + (size_t)(krow0 + (tid >> 3)) * ZLD + ZK + hk * 128 + 8 * (tid & 7);
        pk0 = *(const GAS v4u*)kp; pk1 = *(const GAS v4u*)(kp + 64);
        const bf16* vp = vtb + (size_t)(tid >> 2) * VTLD + tpos0 + 8 * (tid & 3);
        pv0 = *(const GAS v4u*)vp; pv1 = *(const GAS v4u*)(vp + 32); };
    auto commit = [&](int bufi) { LAS unsigned char* kb = lds + bufi * ATT_BUF; LAS unsigned char* vb = kb + AK_BYTES;
        *(LAS v4u*)(kb + (tid >> 3) * AK_STRIDE + 16 * (tid & 7)) = pk0; *(LAS v4u*)(kb + (tid >> 3) * AK_STRIDE + 16 * (tid & 7) + 128) = pk1;
        *(LAS v4u*)(vb + (tid >> 2) * AV_STRIDE + 16 * (tid & 3)) = pv0; *(LAS v4u*)(vb + (tid >> 2) * AV_STRIDE + 16 * (tid & 3) + 64) = pv1; };
    int st = 0, bufi = 0;
    issue(0); commit(0);
    asm volatile("s_waitcnt lgkmcnt(0)" ::: "memory"); __builtin_amdgcn_s_barrier(); asm volatile("" ::: "memory");
    while (st < 10) {
        int nst = st + 1; while (nst < 10 && !step_valid(nst)) ++nst;
        if (nst < 10) issue(nst);
        int krow0, tpos0, kk0; step_geo(st, krow0, tpos0, kk0);
        const bool band = st >= 4;
        const bool live = !band || !(kk0 + 63 < qoff || kk0 > qoff + 31 + 256);
        if (live) {
        const LAS unsigned char* kb = lds + bufi * ATT_BUF; const LAS unsigned char* vb = kb + AK_BYTES;
        af4 S[2][4];
#pragma unroll
        for (int t4 = 0; t4 < 4; ++t4) {
            bf16x8 kf[4];
#pragma unroll
            for (int ks = 0; ks < 4; ++ks) kf[ks] = *(const LAS bf16x8*)(kb + (16 * t4 + c16) * AK_STRIDE + (32 * ks + 8 * g) * 2);
#pragma unroll
            for (int qt = 0; qt < 2; ++qt) {
                af4 sacc = (af4){0.f, 0.f, 0.f, 0.f};
#pragma unroll
                for (int ks = 0; ks < 4; ++ks) sacc = __builtin_amdgcn_mfma_f32_16x16x32_bf16(kf[ks], qf[qt][ks], sacc, 0, 0, 0);
                S[qt][t4] = sacc;
            }
        }
        bf16x8 pf[2][2];
#pragma unroll
        for (int qt = 0; qt < 2; ++qt) {
            if (band) {
                const int qi = qoff + 16 * qt + c16;
#pragma unroll
                for (int t4 = 0; t4 < 4; ++t4)
#pragma unroll
                    for (int r = 0; r < 4; ++r) { const int kk = kk0 + 16 * t4 + 4 * g + r; if (kk < qi || kk > qi + 256) S[qt][t4][r] = -INFINITY; }
            }
            float mx = S[qt][0][0];
#pragma unroll
            for (int t4 = 0; t4 < 4; ++t4)
#pragma unroll
                for (int r = 0; r < 4; ++r) mx = fmaxf(mx, S[qt][t4][r]);
            mx = fmaxf(mx, __shfl_xor(mx, 16)); mx = fmaxf(mx, __shfl_xor(mx, 32));
            const float mnew = fmaxf(mrun[qt], mx), alpha = fexp2(mrun[qt] - mnew);
            mrun[qt] = mnew;
            float ps = 0.f;
#pragma unroll
            for (int t4 = 0; t4 < 4; ++t4)
#pragma unroll
                for (int r = 0; r < 4; ++r) { const float p = fexp2(S[qt][t4][r] - mnew); S[qt][t4][r] = p; ps += p; }
            lpart[qt] = lpart[qt] * alpha + ps;
#pragma unroll
            for (int dt = 0; dt < 8; ++dt) O[qt][dt] *= alpha;
#pragma unroll
            for (int k2 = 0; k2 < 2; ++k2) {
                v4u w; w.x = pk2(S[qt][2 * k2][0], S[qt][2 * k2][1]); w.y = pk2(S[qt][2 * k2][2], S[qt][2 * k2][3]);
                w.z = pk2(S[qt][2 * k2 + 1][0], S[qt][2 * k2 + 1][1]); w.w = pk2(S[qt][2 * k2 + 1][2], S[qt][2 * k2 + 1][3]);
                pf[qt][k2] = __builtin_bit_cast(bf16x8, w);
            }
        }
#pragma unroll
        for (int dt = 0; dt < 8; ++dt) {
#pragma unroll
            for (int k2 = 0; k2 < 2; ++k2) {
                const bf16x8 vf = *(const LAS bf16x8*)(vb + (16 * dt + c16) * AV_STRIDE + (32 * k2 + 8 * g) * 2);
#pragma unroll
                for (int qt = 0; qt < 2; ++qt) O[qt][dt] = __builtin_amdgcn_mfma_f32_16x16x32_bf16(vf, pf[qt][k2], O[qt][dt], 0, 0, 0);
            }
        }
        }
        if (nst < 10) commit(bufi ^ 1);
        asm volatile("s_waitcnt lgkmcnt(0)" ::: "memory"); __builtin_amdgcn_s_barrier(); asm volatile("" ::: "memory");
        bufi ^= 1; st = nst;
    }
#pragma unroll
    for (int qt = 0; qt < 2; ++qt) {
        float L = lpart[qt]; L += __shfl_xor(L, 16); L += __shfl_xor(L, 32);
        L += fexp2(sinkl2 - mrun[qt]);
        const float inv = 1.0f / L;
        const size_t row = (size_t)b * SEQ + nblk * 128 + qoff + 16 * qt + c16;
#pragma unroll
        for (int dt = 0; dt < 8; ++dt) {
            const int d = 16 * dt + 4 * g;
            const v2u gw = *(const GAS v2u*)(Z + row * ZLD + ZGA + hq * 128 + d);
            const float g0 = bflo(gw.x), g1 = bfhi(gw.x), g2 = bflo(gw.y), g3 = bfhi(gw.y);
            v2u w; w.x = pk2(O[qt][dt][0] * inv * siluf_(g0), O[qt][dt][1] * inv * siluf_(g1)); w.y = pk2(O[qt][dt][2] * inv * siluf_(g2), O[qt][dt][3] * inv * siluf_(g3));
            *(GAS v2u*)(OAB + row * D + hq * 128 + d) = w;
        }
    }
}

__device__ __forceinline__ void prep_load_row(const bf16* Z, int row, int c, v4u (&z)[3]) {
#pragma unroll
    for (int qn = 0; qn < 3; ++qn) z[qn] = *(const GAS v4u*)(Z + (size_t)row * ZLD + (qn == 0 ? ZR : (qn == 1 ? ZKB : ZVB)) + c);
}
__device__ __forceinline__ void rwkv_prep_wave(const Args& a, int gw, int NGW, int lane) {
    const bf16* Z = (const bf16*)(a.ws + WS_Z);
    bf16* RK = (bf16*)(a.ws + WS_RKVK);
    const int c = (gw & 3) * 512 + 8 * lane;
    float cw[3][3][8], kkw[8];
#pragma unroll
    for (int qn = 0; qn < 3; ++qn)
#pragma unroll
        for (int tap = 0; tap < 3; ++tap)
#pragma unroll
            for (int h = 0; h < 2; ++h) { const af4 t = *(const GAS af4*)(a.in[I_CONV] + tap * 3 * BW + qn * BW + c + 4 * h);
#pragma unroll
                for (int e = 0; e < 4; ++e) cw[qn][tap][4 * h + e] = t[e]; }
#pragma unroll
    for (int h = 0; h < 2; ++h) { const af4 t = *(const GAS af4*)(a.in[I_KK] + c + 4 * h);
#pragma unroll
        for (int e = 0; e < 4; ++e) kkw[4 * h + e] = t[e]; }
    const int nq = NGW >> 2, wq = gw >> 2, per = (MALL + nq - 1) / nq;
    const int r0 = wq * per, r1 = (r0 + per < MALL) ? r0 + per : MALL;
    if (r0 >= r1) return;
    const v4u z4 = {0u, 0u, 0u, 0u};
    v4u P[3] = {z4, z4, z4}, C[3], N[3] = {z4, z4, z4}, N2[3] = {z4, z4, z4}, N3[3];
    if (r0 > 0) prep_load_row(Z, r0 - 1, c, P);
    prep_load_row(Z, r0, c, C);
    if (r0 + 1 < MALL) prep_load_row(Z, r0 + 1, c, N);
    if (r0 + 2 < MALL && r0 + 2 <= r1) prep_load_row(Z, r0 + 2, c, N2);
    for (int row = r0; row < r1; ++row) {
#pragma unroll
        for (int qn = 0; qn < 3; ++qn) N3[qn] = z4;
        if (row + 3 < MALL && row + 3 <= r1) prep_load_row(Z, row + 3, c, N3);
        bool hp, hn;
        if (row < MLAT) { const int t = row & (SEQ - 1); hp = t > 0; hn = t < SEQ - 1; } else { const int l = (row - MLAT) & (CTXL - 1); hp = l > 0; hn = l < CTXL - 1; }
        float outv[3][8];
#pragma unroll
        for (int qn = 0; qn < 3; ++qn) {
            float x0[8], x1[8], x2[8];
            unpack8(hp ? P[qn] : z4, x0); unpack8(C[qn], x1); unpack8(hn ? N[qn] : z4, x2);
#pragma unroll
            for (int e = 0; e < 8; ++e) outv[qn][e] = x0[e] * cw[qn][0][e] + x1[e] * cw[qn][1][e] + x2[e] * cw[qn][2][e];
        }
        float kk[8]; float ss = 0.f;
#pragma unroll
        for (int e = 0; e < 8; ++e) { kk[e] = outv[1][e] * kkw[e]; ss += kk[e] * kk[e]; }
        ss = sum8(ss);
        const float inv = 1.0f / fmaxf(sqrtf(ss), 1e-12f);
#pragma unroll
        for (int e = 0; e < 8; ++e) kk[e] *= inv;
        const size_t o = (size_t)row * BW + c, QS = (size_t)MALL * BW;
        *(GAS v4u*)(RK + o) = pack8(outv[0]); *(GAS v4u*)(RK + QS + o) = pack8(outv[1]); *(GAS v4u*)(RK + 2 * QS + o) = pack8(outv[2]); *(GAS v4u*)(RK + 3 * QS + o) = pack8(kk);
#pragma unroll
        for (int qn = 0; qn < 3; ++qn) { P[qn] = C[qn]; C[qn] = N[qn]; N[qn] = N2[qn]; N2[qn] = N3[qn]; }
    }
}

typedef short bf16x4 __attribute__((ext_vector_type(4)));
typedef __bf16 bf16v4_t __attribute__((ext_vector_type(4)));
typedef __bf16 bf16v2c_t __attribute__((ext_vector_type(2)));
__device__ __forceinline__ bf16x4 cvt4(const af4 x) {
    v2u w; w.x = __builtin_bit_cast(unsigned, __builtin_convertvector((f32x2){x[0], x[1]}, bf16v2c_t)); w.y = __builtin_bit_cast(unsigned, __builtin_convertvector((f32x2){x[2], x[3]}, bf16v2c_t));
    return __builtin_bit_cast(bf16x4, w); }
__device__ __forceinline__ bf16x4 lds4(const LAS unsigned char* p) { return __builtin_bit_cast(bf16x4, *(const LAS v2u*)p); }
#define MFMA16(a, b, c) __builtin_amdgcn_mfma_f32_16x16x16bf16_1k(a, b, c, 0, 0, 0)
constexpr int CRS = 144;
constexpr int CR_P = 0, CR_RT = 2304, CR_Q = 4608, CR_K = 6912, CR_V = 9216, CR_MKP = 11520, CR_MKR = 12032, CR_MQR = 12544, CR_TT = 13056, CR_G16 = 13568, CR_MF = 13824, CR_BYTES = 15360;
constexpr int CS_SCR = 8 * CR_BYTES, CS_SCR_BYTES = 16;
static_assert(CS_SCR + 4 * CS_SCR_BYTES + 64 <= LDSCTL_OFF, "chunked-scan LDS map");

struct ScanCtx { const bf16 *pE, *pA, *pKK, *pK, *pR, *pV; bf16* YS; const float* ka; int b, h, dir; };
__device__ __forceinline__ int cs_rowof(const ScanCtx& c, int s) { return s < CTXL ? (MLAT + c.b * CTXL + (c.dir ? (CTXL - 1 - s) : s)) : (c.b * SEQ + (c.dir ? (SEQ - 1 - (s - CTXL)) : (s - CTXL))); }
typedef __bf16 bf16v2_t __attribute__((ext_vector_type(2)));
__device__ __forceinline__ unsigned cvt2(float lo, float hi) { return __builtin_bit_cast(unsigned, __builtin_convertvector((f32x2){lo, hi}, bf16v2_t)); }
template <int N> __device__ __forceinline__ float dpp_shr(float x) { return __builtin_bit_cast(float, __builtin_amdgcn_update_dpp(0, __builtin_bit_cast(int, x), 0x110 + N, 0xF, 0xF, false)); }

struct PrepRaw { v4u e[2], a[2], kk[2], k[2], r[2], v[2]; };
__device__ __forceinline__ void cs_prep_load(const ScanCtx& c, int chunk, int lane, PrepRaw& R) {
    const int row = cs_rowof(c, 16 * chunk) + (lane & 15) * (c.dir ? -1 : 1);
    const size_t o = (size_t)row * BW + c.h * 64 + 16 * (lane >> 4);
#pragma unroll
    for (int i = 0; i < 2; ++i) { R.e[i] = *(const GAS v4u*)(c.pE + o + 8 * i); R.a[i] = *(const GAS v4u*)(c.pA + o + 8 * i); R.kk[i] = *(const GAS v4u*)(c.pKK + o + 8 * i);
        R.k[i] = *(const GAS v4u*)(c.pK + o + 8 * i); R.r[i] = *(const GAS v4u*)(c.pR + o + 8 * i); R.v[i] = *(const GAS v4u*)(c.pV + o + 8 * i); }
}
template <bool LOAD>
__device__ __forceinline__ void cs_prep_chunk(const ScanCtx& c, LAS unsigned char* rec, int next_chunk, int lane, const float (&kaw)[16], PrepRaw& R, PrepRaw& Rn) {
    if (LOAD) cs_prep_load(c, next_chunk, lane, Rn);
    const int t = lane & 15, kq = lane >> 4;
    const float t0 = (t == 0) ? 1.0f : 0.0f;
#pragma unroll
    for (int i = 0; i < 2; ++i) {
        float ef[8], af[8], kkf[8], kf[8], rf[8], gam[8], inv[8], gp[8];
        unpack8(R.e[i], ef); unpack8(R.a[i], af); unpack8(R.kk[i], kkf); unpack8(R.k[i], kf); unpack8(R.r[i], rf);
#pragma unroll
        for (int j = 0; j < 8; ++j) { float x = ef[j]; x += dpp_shr<1>(x); x += dpp_shr<2>(x); x += dpp_shr<4>(x); x += dpp_shr<8>(x);
            gam[j] = fexp2(-x); inv[j] = fexp2(x); gp[j] = dpp_shr<1>(gam[j]) + t0; }
        if (t == 15) { LAS float* gd = (LAS float*)(rec + CR_G16) + 16 * kq + 8 * i; *(LAS f32x4*)gd = (f32x4){gam[0], gam[1], gam[2], gam[3]}; *(LAS f32x4*)(gd + 4) = (f32x4){gam[4], gam[5], gam[6], gam[7]}; }
        float po[8], ro[8], qo[8], ko[8];
#pragma unroll
        for (int j = 0; j < 8; j += 2) {
            const f32x2 G = {gam[j], gam[j + 1]}, I = {inv[j], inv[j + 1]}, GP = {gp[j], gp[j + 1]}, KK = {kkf[j], kkf[j + 1]}, A = {af[j], af[j + 1]}, K = {kf[j], kf[j + 1]}, Rr = {rf[j], rf[j + 1]}, KA = {kaw[8 * i + j], kaw[8 * i + j + 1]};
            const f32x2 p = GP * KK, q = (KK * A) * (-I), k = (K * ((A - 1.0f) * KA + 1.0f)) * I, r = G * Rr;
            po[j] = p.x; po[j + 1] = p.y; qo[j] = q.x; qo[j + 1] = q.y; ko[j] = k.x; ko[j + 1] = k.y; ro[j] = r.x; ro[j + 1] = r.y;
        }
        const int off = t * CRS + (16 * kq + 8 * i) * 2;
        v4u w;
        w.x = cvt2(po[0], po[1]); w.y = cvt2(po[2], po[3]); w.z = cvt2(po[4], po[5]); w.w = cvt2(po[6], po[7]); *(LAS v4u*)(rec + CR_P + off) = w;
        w.x = cvt2(ro[0], ro[1]); w.y = cvt2(ro[2], ro[3]); w.z = cvt2(ro[4], ro[5]); w.w = cvt2(ro[6], ro[7]); *(LAS v4u*)(rec + CR_RT + off) = w;
        w.x = cvt2(qo[0], qo[1]); w.y = cvt2(qo[2], qo[3]); w.z = cvt2(qo[4], qo[5]); w.w = cvt2(qo[6], qo[7]); *(LAS v4u*)(rec + CR_Q + off) = w;
        w.x = cvt2(ko[0], ko[1]); w.y = cvt2(ko[2], ko[3]); w.z = cvt2(ko[4], ko[5]); w.w = cvt2(ko[6], ko[7]); *(LAS v4u*)(rec + CR_K + off) = w;
        *(LAS v4u*)(rec + CR_V + off) = R.v[i];
    }
    asm volatile("" ::: "memory");
    const int c16 = lane & 15, g = lane >> 4;
    af4 wt = {0.f, 0.f, 0.f, 0.f}, vt = wt, mkp = wt, mkr = wt, mqr = wt;
#pragma unroll
    for (int kt = 0; kt < 4; ++kt) {
        const int off = c16 * CRS + (16 * kt + 4 * g) * 2;
        const bf16x4 qa = lds4(rec + CR_Q + off), kaa = lds4(rec + CR_K + off), pb = lds4(rec + CR_P + off), rb = lds4(rec + CR_RT + off);
        wt = MFMA16(pb, qa, wt); vt = MFMA16(qa, pb, vt); mkp = MFMA16(kaa, pb, mkp); mkr = MFMA16(kaa, rb, mkr); mqr = MFMA16(qa, rb, mqr);
    }
#pragma unroll
    for (int r = 0; r < 4; ++r) { const int sI = 4 * g + r;
        if (!(c16 < sI)) wt[r] = 0.f;
        if (!(sI < c16)) { vt[r] = 0.f; mkp[r] = 0.f; }
        if (!(sI <= c16)) { mkr[r] = 0.f; mqr[r] = 0.f; } }
    *(LAS v2u*)(rec + CR_MKP + c16 * 32 + 8 * g) = __builtin_bit_cast(v2u, cvt4(mkp));
    *(LAS v2u*)(rec + CR_MKR + c16 * 32 + 8 * g) = __builtin_bit_cast(v2u, cvt4(mkr));
    *(LAS v2u*)(rec + CR_MQR + c16 * 32 + 8 * g) = __builtin_bit_cast(v2u, cvt4(mqr));
    const af4 z4 = {0.f, 0.f, 0.f, 0.f};
    const bf16x4 w1 = cvt4(wt), v1 = cvt4(vt);
    const af4 W2 = MFMA16(v1, w1, z4), V2 = MFMA16(w1, v1, z4);
    const bf16x4 w2 = cvt4(W2), v2 = cvt4(V2);
    const af4 W4 = MFMA16(v2, w2, z4), V4 = MFMA16(w2, v2, z4);
    const bf16x4 w4 = cvt4(W4), v4 = cvt4(V4);
    af4 pT = MFMA16(w4, v4, z4);
#pragma unroll
    for (int r = 0; r < 4; ++r) pT[r] += (4 * g + r == c16) ? 1.0f : 0.0f;
    pT = MFMA16(w4, cvt4(pT), pT);
    pT = MFMA16(w2, cvt4(pT), pT);
    pT = MFMA16(w1, cvt4(pT), pT);
    *(LAS v2u*)(rec + CR_TT + c16 * 32 + 8 * g) = __builtin_bit_cast(v2u, cvt4(pT));
    asm volatile("" ::: "memory");
}
__device__ __forceinline__ bf16x4 gath4(const LAS unsigned char* m, int g, int c16, int col0) {
    const LAS unsigned char* p = m + (4 * g + (c16 >> 2)) * CRS + (col0 + 4 * (c16 & 3)) * 2;
    return __builtin_amdgcn_ds_read_tr16_b64_v4i16((LAS bf16x4*)p);
}
struct SFrag { bf16x4 p[4], rt[4], kf[4], qf[4], vf, mkp, mkr, tt, mqr; f32x4 gm[4]; };
__device__ __forceinline__ void cs_state_load(const LAS unsigned char* rec, int w, int lane, SFrag& F) {
    const int c16 = lane & 15, g = lane >> 4;
#pragma unroll
    for (int kt = 0; kt < 4; ++kt) { const int off = c16 * CRS + (16 * kt + 4 * g) * 2; F.p[kt] = lds4(rec + CR_P + off); F.rt[kt] = lds4(rec + CR_RT + off); }
    F.vf = gath4(rec + CR_V, g, c16, 16 * w);
    F.mkp = lds4(rec + CR_MKP + c16 * 32 + 8 * g); F.mkr = lds4(rec + CR_MKR + c16 * 32 + 8 * g); F.tt = lds4(rec + CR_TT + c16 * 32 + 8 * g); F.mqr = lds4(rec + CR_MQR + c16 * 32 + 8 * g);
#pragma unroll
    for (int kt = 0; kt < 4; ++kt) { F.kf[kt] = gath4(rec + CR_K, g, c16, 16 * kt); F.qf[kt] = gath4(rec + CR_Q, g, c16, 16 * kt); F.gm[kt] = *(const LAS f32x4*)(rec + CR_G16 + (16 * kt + 4 * g) * 4); }
}
__device__ __forceinline__ void cs_state_compute(const ScanCtx& c, const SFrag& F, int w, int lane, af4 (&ST)[4], int chunk, bool store) {
    const int c16 = lane & 15, g = lane >> 4;
    bf16x4 sb[4];
#pragma unroll
    for (int kt = 0; kt < 4; ++kt) sb[kt] = cvt4(ST[kt]);
    af4 X = {0.f, 0.f, 0.f, 0.f}, Y = X;
#pragma unroll
    for (int kt = 0; kt < 4; ++kt) { X = MFMA16(F.p[kt], sb[kt], X); Y = MFMA16(F.rt[kt], sb[kt], Y); }
    X = MFMA16(F.mkp, F.vf, X);
    Y = MFMA16(F.mkr, F.vf, Y);
    const bf16x4 xb = cvt4(X);
    af4 U = {0.f, 0.f, 0.f, 0.f};
    U = MFMA16(F.tt, xb, U);
    const bf16x4 ub = cvt4(U);
    Y = MFMA16(F.mqr, ub, Y);
#pragma unroll
    for (int kt = 0; kt < 4; ++kt) {
        af4 sN = ST[kt];
        sN = MFMA16(F.kf[kt], F.vf, sN);
        sN = MFMA16(F.qf[kt], ub, sN);
        ST[kt] = sN * F.gm[kt];
    }
    if (store) {
        const int row0 = cs_rowof(c, 16 * chunk), rst = c.dir ? -1 : 1;
        bf16* yb = c.YS + (size_t)row0 * BW + c.h * 64 + 16 * w;
        const unsigned y01 = cvt2(Y[0], Y[1]), y23 = cvt2(Y[2], Y[3]);
        const int ro = (4 * g) * rst * BW + c16;
        yb[ro] = (bf16)(y01 & 0xffffu); yb[ro + rst * BW] = (bf16)(y01 >> 16); yb[ro + 2 * rst * BW] = (bf16)(y23 & 0xffffu); yb[ro + 3 * rst * BW] = (bf16)(y23 >> 16);
    }
}

__device__ __forceinline__ void scan_chunked(const Args& a, LAS unsigned char* lds, int sid, int tid) {
    ScanCtx c; c.dir = sid & 1; c.h = (sid >> 1) & 31; c.b = sid >> 6;
    const bf16* RK = (const bf16*)(a.ws + WS_RKVK); const bf16* EK = (const bf16*)(a.ws + WS_EKK); const size_t QS = (size_t)MALL * BW;
    c.pKK = RK + 3 * QS; c.pE = EK + (size_t)c.dir * QS; c.pA = EK + (size_t)(2 + c.dir) * QS; c.pK = RK + QS; c.pR = RK; c.pV = RK + 2 * QS;
    c.YS = (bf16*)(a.ws + WS_YS) + (size_t)c.dir * MLAT * BW; c.ka = a.in[I_KA];
    const int wave = __builtin_amdgcn_readfirstlane(tid >> 6), lane = tid & 63;
    constexpr int NG = (CTXL + SEQ) / 64;
    static_assert(NG % 2 == 0, "the group loop is unrolled by two");
#define CS_BAR() do { asm volatile("s_waitcnt lgkmcnt(0)" ::: "memory"); __builtin_amdgcn_s_barrier(); asm volatile("" ::: "memory"); } while (0)
    if (wave >= 4) {
        PrepRaw RA, RB; float kaw[16];
#pragma unroll
        for (int j = 0; j < 16; ++j) kaw[j] = c.ka[c.h * 64 + 16 * (lane >> 4) + j];
        const int pw = wave - 4;
        cs_prep_load(c, pw, lane, RA); cs_prep_chunk<true>(c, lds + pw * CR_BYTES, 4 + pw, lane, kaw, RA, RB);
        CS_BAR();
        for (int gi = 0; gi < NG - 2; gi += 2) {
            cs_prep_chunk<true>(c, lds + (4 + pw) * CR_BYTES, 4 * (gi + 2) + pw, lane, kaw, RB, RA);
            CS_BAR();
            cs_prep_chunk<true>(c, lds + pw * CR_BYTES, 4 * (gi + 3) + pw, lane, kaw, RA, RB);
            CS_BAR();
        }
        cs_prep_chunk<false>(c, lds + (4 + pw) * CR_BYTES, 0, lane, kaw, RB, RA);
        CS_BAR();
        CS_BAR();
    } else {
        af4 ST[4];
#pragma unroll
        for (int kt = 0; kt < 4; ++kt) ST[kt] = (af4){0.f, 0.f, 0.f, 0.f};
        CS_BAR();
        for (int gi = 0; gi < NG; ++gi) {
            const LAS unsigned char* rg = lds + (gi & 1) * 4 * CR_BYTES; const bool st = gi >= CTXL / 64;
            SFrag F0, F1;
            cs_state_load(rg, wave, lane, F0);
            cs_state_load(rg + CR_BYTES, wave, lane, F1);     cs_state_compute(c, F0, wave, lane, ST, 4 * gi, st);
            cs_state_load(rg + 2 * CR_BYTES, wave, lane, F0); cs_state_compute(c, F1, wave, lane, ST, 4 * gi + 1, st);
            cs_state_load(rg + 3 * CR_BYTES, wave, lane, F1); cs_state_compute(c, F0, wave, lane, ST, 4 * gi + 2, st);
            cs_state_compute(c, F1, wave, lane, ST, 4 * gi + 3, st);
            CS_BAR();
        }
    }
#undef CS_BAR
}

struct RoIn { v4u y0, y1, r, k, v, g; };
__device__ __forceinline__ void ro_load(const Args& a, int row, int c, RoIn& in) {
    const bf16* Z = (const bf16*)(a.ws + WS_Z); const bf16* RK = (const bf16*)(a.ws + WS_RKVK); const bf16* YS = (const bf16*)(a.ws + WS_YS);
    const size_t o = (size_t)row * BW + c, QS = (size_t)MALL * BW;
    in.y0 = *(const GAS v4u*)(YS + o); in.y1 = *(const GAS v4u*)(YS + (size_t)MLAT * BW + o);
    in.r = *(const GAS v4u*)(RK + o); in.k = *(const GAS v4u*)(RK + QS + o); in.v = *(const GAS v4u*)(RK + 2 * QS + o);
    in.g = *(const GAS v4u*)(Z + (size_t)row * ZLD + ZGB + c);
}
__device__ __forceinline__ void readout_wave(const Args& a, int gw, int NGW, int lane) {
    bf16* OAB = (bf16*)(a.ws + WS_OAB);
    const int c = (gw & 3) * 512 + 8 * lane;
    float rk[8], gw_[8], gbias[8];
#pragma unroll
    for (int h = 0; h < 2; ++h) { const af4 t0 = *(const GAS af4*)(a.in[I_RK] + c + 4 * h), t1 = *(const GAS af4*)(a.in[I_GNW] + c + 4 * h), t2 = *(const GAS af4*)(a.in[I_GNB] + c + 4 * h);
#pragma unroll
        for (int e = 0; e < 4; ++e) { rk[4 * h + e] = t0[e]; gw_[4 * h + e] = t1[e]; gbias[4 * h + e] = t2[e]; } }
    RoIn cur, nxt;
    int item = gw;
    if (item < MLAT * 4) ro_load(a, item >> 2, c, cur);
    while (item < MLAT * 4) {
        const int nitem = item + NGW;
        if (nitem < MLAT * 4) ro_load(a, nitem >> 2, c, nxt);
        const int row = item >> 2;
        float y0[8], y1[8], r[8], k[8], vv[8], gb[8];
        unpack8(cur.y0, y0); unpack8(cur.y1, y1); unpack8(cur.r, r); unpack8(cur.k, k); unpack8(cur.v, vv); unpack8(cur.g, gb);
        float s = 0.f, bon = 0.f;
#pragma unroll
        for (int e = 0; e < 8; ++e) { y0[e] += y1[e]; s += y0[e]; bon += r[e] * k[e] * rk[e]; }
        s = sum8(s); bon = sum8(bon);
        const float mean = s * (1.0f / 64.0f); float q = 0.f;
#pragma unroll
        for (int e = 0; e < 8; ++e) { y0[e] -= mean; q += y0[e] * y0[e]; }
        q = sum8(q);
        const float rstd = 1.0f / sqrtf(q * (1.0f / 64.0f) + 64e-5f);
        float outv[8];
#pragma unroll
        for (int e = 0; e < 8; ++e) outv[e] = (y0[e] * rstd * gw_[e] + gbias[e] + bon * vv[e]) * siluf_(gb[e]);
        *(GAS v4u*)(OAB + (size_t)row * D + BW + c) = pack8(outv);
        cur = nxt; item = nitem;
    }
}

__global__ void __launch_bounds__(NTHREADS, 2) fwd(Args a) {
    extern __shared__ __attribute__((aligned(16))) unsigned char lds_raw[];
    LAS unsigned char* lds = (LAS unsigned char*)lds_raw;
    const int G = gridDim.x, bx = blockIdx.x;
    unsigned char* ws = a.ws;
    volatile LAS unsigned* MISC = (volatile LAS unsigned*)(lds + LDSCTL_OFF);
    if (threadIdx.x < 64) MISC[threadIdx.x] = 0u;
    __syncthreads();
    XcdBarrier bar; bar.bar = (unsigned*)(ws + WS_CTL) + CW_BAR; bar.x = 0; bar.st = nullptr;
    if (MK_N_LAUNCHES == 1) bar = xcd_barrier_post((unsigned*)(ws + WS_CTL) + CW_BAR, MISC + 8);
    const int lo = a.ph_lo, hi = a.ph_hi;
#ifdef ONLY_PHASE
#define IN(k) ((k) == ONLY_PHASE)
#else
#define IN(k) (lo <= (k) && (k) < hi)
#endif
#define REPS(k) _Pragma("unroll") for (int _rep = 0; _rep < ((k) == REP_PHASE ? REP_COUNT : 1); ++_rep)
#define SEAM(k) do { if (IN(k) && IN((k) + 1)) xcd_barrier(bar); } while (0)
    const int NGW = G * NWAVES;
    float* modv = (float*)(ws + WS_MODV);

    REPS(0) { if (_rep) xcd_barrier(bar);
    if (IN(0)) { p0_phase(a, lds); }
    }
    SEAM(0);
    REPS(1) { if (_rep) xcd_barrier(bar);
    if (IN(1)) { norm_phase(a, lds, 0, a.in[I_X], a.in[I_CTX], MALL, nullptr, nullptr); }
    }
    SEAM(1);
    REPS(2) { if (_rep) xcd_barrier(bar);
    if (IN(2)) {
        pg8::Gemm g{(const bf16*)(ws + WS_H), (const bf16*)(ws + WS_WIN0), MALL, ZLD, D, D}; pg8::StaticOrder S; S.init(MALL, ZLD, G, bx);
        EpiZ E{(bf16*)(ws + WS_Z), (bf16*)(ws + WS_VTA), (const float*)(ws + WS_ROPE)};
        pg8::gemm_phase<EpiZ, pg8::StaticOrder, true, true>(lds, g, S, E);
    }
    }
#ifdef PROBE_NULL_G1
    { xcd_barrier(bar);
        pg8::Gemm g{(const bf16*)(ws + WS_H), (const bf16*)(ws + WS_WIN0), MALL, ZLD, D, D}; pg8::StaticOrder S; S.init(MALL, ZLD, G, bx);
        EpiNull E{};
        pg8::gemm_phase<EpiNull, pg8::StaticOrder, true, true>(lds, g, S, E); }
#endif
    SEAM(2);
    REPS(3) { if (_rep) xcd_barrier(bar);
    if (IN(3)) {
        const int tid = my_tid(), lane = tid & 63, wave = __builtin_amdgcn_readfirstlane(tid >> 6), gw = bx * NWAVES + wave;
        rwkv_prep_wave(a, gw, NGW, lane);
        for (int u = ATT_P5 + bx; u < 1024; u += G) attn_unit(a, lds, u, tid, lane, wave);
    }
    }
    REPS(4) { if (_rep) xcd_barrier(bar);
    if (IN(4)) {
        int Kl = 128; asm volatile("" : "+s"(Kl));
        pg8::Gemm g{(const bf16*)(ws + WS_Z) + ZDL, (const bf16*)(ws + WS_WLORA), MALL, 8192, Kl, ZLD, 3, 256}; pg8::StaticOrder S; S.init(MALL, 8192, G, bx);
        EpiLora E{a.in[I_W0], a.in[I_A0], (bf16*)(ws + WS_EKK)};
        pg8::gemm_phase<EpiLora, pg8::StaticOrder, true, true>(lds, g, S, E);
    }
    }
    SEAM(4);
    REPS(5) { if (_rep) xcd_barrier(bar);
    if (IN(5)) {
        const int tid = my_tid(), lane = tid & 63, wave = __builtin_amdgcn_readfirstlane(tid >> 6);
        const int nsb = G >= 256 ? 128 : G;
        if (bx < nsb) for (int sid = bx; sid < 128; sid += nsb) scan_chunked(a, lds, sid, tid);
        const int tb = G >= 256 ? bx - 128 : bx, ntb = G >= 256 ? G - 128 : G;
        if (tb >= 0) {
            LAS float* scr = (LAS float*)(lds + wave * 16384);
            float x[32], xn[32];
            for (int u = tb; u < ATT_P5; u += ntb) attn_unit(a, lds, u, tid, lane, wave);
            static_assert(L1_P5 <= TR_I2, "the phase-5 items are all gm_w_in items");
            const int jst = ntb * NWAVES; int j = tb * NWAVES + wave;
            auto ldi = [&](int jj, float (&xx)[32]) { tr_load_nc(a.in[I_GWIN], 3 * CW, 2, jj < L1_P5 ? jj : L1_P5 - 1, lane, TR_NB2, xx); };
            auto sti = [&](int jj, const float (&xx)[32]) { tr_store((bf16*)(a.ws + WS_WGIN), D, scr, jj, lane, TR_NB2, xx); };
            float xc[32];
            ldi(j, x); ldi(j + jst, xn);
            while (j + 2 * jst < L1_P5) {
                ldi(j + 2 * jst, xc); sti(j, x);
                ldi(j + 3 * jst, x);  sti(j + jst, xn);
                ldi(j + 4 * jst, xn); sti(j + 2 * jst, xc);
                j += 3 * jst;
            }
            if (j < L1_P5) sti(j, x);
            if (j + jst < L1_P5) sti(j + jst, xn);
        }
    }
    }
    SEAM(5);
    REPS(6) { if (_rep) xcd_barrier(bar);
    if (IN(6)) { const int tid = my_tid(), lane = tid & 63, gw = bx * NWAVES + __builtin_amdgcn_readfirstlane(tid >> 6); readout_wave(a, gw, NGW, lane); }
    }
    SEAM(6);
    REPS(7) { if (_rep) xcd_barrier(bar);
    if (IN(7)) {
        pg8::Gemm g{(const bf16*)(ws + WS_OAB), (const bf16*)(ws + WS_WOUT0), MLAT, D, D, D}; pg8::StaticOrder S; S.init(MLAT, D, G, bx);
        EpiGateOut E{(bf16*)(ws + WS_Y0), modv + 2 * D};
        pg8::gemm_phase<EpiGateOut, pg8::StaticOrder, true, true>(lds, g, S, E);
    }
    }
    SEAM(7);
    REPS(8) { if (_rep) xcd_barrier(bar);
    if (IN(8)) { norm_phase(a, lds, 1, a.in[I_X], nullptr, MLAT, (const bf16*)(ws + WS_Y0), (bf16*)(ws + WS_X1)); }
    }
    SEAM(8);
    REPS(9) { if (_rep) xcd_barrier(bar);
    if (IN(9)) {
        pg8::Gemm g{(const bf16*)(ws + WS_WGIN), (const bf16*)(ws + WS_H), CW, MLAT, D, D}; pg8::StaticOrder S; S.init(CW, MLAT, G, bx);
        EpiVT E{(bf16*)(ws + WS_VT), (float*)(ws + WS_STATP)};
        pg8::gemm_phase<EpiVT, pg8::StaticOrder, true, true>(lds, g, S, E);
    }
    }
    SEAM(9);
    REPS(10) { if (_rep) xcd_barrier(bar);
    if (IN(10)) {
        const int tid = my_tid(), lane = tid & 63, gw = bx * NWAVES + __builtin_amdgcn_readfirstlane(tid >> 6);
        const float* sp = (const float*)(ws + WS_STATP); float* st = (float*)(ws + WS_STATS);
        for (int row = gw; row < MLAT; row += NGW) {
            float s1 = 0.f, s2 = 0.f;
            { const f32x2 p = *(const GAS f32x2*)(sp + ((size_t)row * 96 + lane) * 2); s1 = p.x; s2 = p.y; }
            if (lane < 32) { const f32x2 p = *(const GAS f32x2*)(sp + ((size_t)row * 96 + 64 + lane) * 2); s1 += p.x; s2 += p.y; }
            s1 = wave_sum(s1); s2 = wave_sum(s2);
            const float mean = s1 * (1.0f / CW), var = fmaxf(s2 * (1.0f / CW) - mean * mean, 0.f);
            const float rstd = 1.0f / sqrtf(var + 1e-5f);
            if (lane == 0) { float* sq = st + (size_t)(row >> 1) * 4 + (row & 1); sq[0] = -mean * rstd; sq[2] = rstd; }
        }
    }
    }
    SEAM(10);
    REPS(11) { if (_rep) xcd_barrier(bar);
    if (IN(11)) {
        pg8::Gemm g{(const bf16*)(ws + WS_H), (const bf16*)(ws + WS_WGIN) + (size_t)CW * D, MLAT, 2 * CW, D, D}; pg8::StaticOrder S; S.init(MLAT, 2 * CW, G, bx);
        EpiGate E{(const bf16*)(ws + WS_VT), (const float*)(ws + WS_STATS), (const bf16*)(ws + WS_WSB), a.in[I_BS], a.in[I_LNG], a.in[I_LNB], (bf16*)(ws + WS_Y)};
        pg8::gemm_phase<EpiGate, pg8::StaticOrder, true, true>(lds, g, S, E);
    }
    }
    SEAM(11);
    REPS(12) { if (_rep) xcd_barrier(bar);
    if (IN(12)) {
        pg8::Gemm g{(const bf16*)(ws + WS_Y), (const bf16*)(ws + WS_WGOUT), MLAT, D, CW, CW}; pg8::StaticOrder S; S.init(MLAT, D, G, bx);
        EpiGateOut E{(bf16*)(ws + WS_Y1), modv + 3 * 3 * D + 2 * D};
        pg8::gemm_phase<EpiGateOut, pg8::StaticOrder, true, true>(lds, g, S, E);
    }
    }
    SEAM(12);
    if (IN(13)) {
        const int tid = my_tid(), lane = tid & 63, gw = bx * NWAVES + __builtin_amdgcn_readfirstlane(tid >> 6);
        const float* fg = a.in[I_FING]; const bf16* X1 = (const bf16*)(ws + WS_X1); const bf16* Y1 = (const bf16*)(ws + WS_Y1);
        f32x4 v[16]; v2u xv[16], xn[16], yv[16], yn[16];
        auto loadrow = [&](int row, v2u (&dst)[16], v2u (&yd)[16]) {
            const GAS v2u* xp = (const GAS v2u*)(X1 + (size_t)row * D) + lane; const GAS v2u* yp = (const GAS v2u*)(Y1 + (size_t)row * D) + lane;
#pragma unroll
            for (int q = 0; q < 16; ++q) { dst[q] = xp[64 * q]; yd[q] = yp[64 * q]; }
        };
        int row = gw;
        if (row < MLAT) loadrow(row, xv, yv);
        while (row < MLAT) {
            const int nrow = row + NGW;
            if (nrow < MLAT) loadrow(nrow, xn, yn);
            GAS f32x4* op = (GAS f32x4*)(a.out + (size_t)row * D) + lane;
            float s = 0.f;
#pragma unroll
            for (int q = 0; q < 16; ++q) { v[q] = (f32x4){bflo(xv[q].x), bfhi(xv[q].x), bflo(xv[q].y), bfhi(xv[q].y)} + (f32x4){bflo(yv[q].x), bfhi(yv[q].x), bflo(yv[q].y), bfhi(yv[q].y)}; s += (v[q].x * v[q].x + v[q].y * v[q].y) + (v[q].z * v[q].z + v[q].w * v[q].w); }
            const float rstd = 1.0f / sqrtf(wave_sum(s) * (1.0f / D) + 1e-6f);
#pragma unroll
            for (int q = 0; q < 16; ++q) { const f32x4 gg = *(const GAS f32x4*)(fg + 4 * lane + 256 * q); op[64 * q] = v[q] * rstd * gg; }
#pragma unroll
            for (int q = 0; q < 16; ++q) { xv[q] = xn[q]; yv[q] = yn[q]; }
            row = nrow;
        }
    }
#undef IN
#undef SEAM
}

extern "C" void kernel_launch(void* const* d_in, const int* in_sizes, int n_in, void* d_out, int out_size, void* d_ws, size_t ws_size, hipStream_t stream) {
    static int grid = 0;
    if (grid == 0) {
        if (n_in != 27 || in_sizes[0] != MLAT * D || out_size != MLAT * D || ws_size < WS_END) { fprintf(stderr, "kernel_launch: unexpected shapes (n_in %d, ws %zu < %zu?)\n", n_in, ws_size, (size_t)WS_END); grid = -1; return; }
        int dev = 0, cus = 0, per_cu = 0;
        if (hipGetDevice(&dev) != hipSuccess || hipDeviceGetAttribute(&cus, hipDeviceAttributeMultiprocessorCount, dev) != hipSuccess) { grid = -1; return; }
        if (hipFuncSetAttribute((const void*)fwd, hipFuncAttributeMaxDynamicSharedMemorySize, LDS_BYTES) != hipSuccess) { fprintf(stderr, "kernel_launch: hipFuncSetAttribute failed\n"); grid = -1; return; }
        if (hipOccupancyMaxActiveBlocksPerMultiprocessor(&per_cu, (const void*)fwd, NTHREADS, LDS_BYTES) != hipSuccess || per_cu < 1) { fprintf(stderr, "kernel_launch: occupancy query says %d\n", per_cu); }
        (void)hipGetLastError();
        grid = cus;
    }
    if (grid < 0) return;
    if (hipMemsetAsync((char*)d_ws + WS_CTL, 0, CTL_ZERO_BYTES, stream) != hipSuccess) return;
    Args a{};
    for (int i = 0; i < 27; ++i) a.in[i] = (const float*)d_in[i];
    a.out = (float*)d_out; a.ws = (unsigned char*)d_ws;
    if (MK_N_LAUNCHES == 1) { a.ph_lo = 0; a.ph_hi = NPHASE; hipLaunchKernelGGL(fwd, dim3(grid), dim3(NTHREADS), LDS_BYTES, stream, a); }
    else for (int p = 0; p < NPHASE; ++p) { a.ph_lo = p; a.ph_hi = p + 1; hipLaunchKernelGGL(fwd, dim3(grid), dim3(NTHREADS), LDS_BYTES, stream, a); }
}
```
